# Optimizing an MI355X kernel written in HIP

```python
import math
import jax
import jax.numpy as jnp
from jax import lax
import numpy as np


D_MODEL = 1024
BATCH = 4
SEQ = 8192
DEPTH = 2

DEEPNORM_ALPHA = (2 * DEPTH) ** 0.25
DEEPNORM_BETA = (8 * DEPTH) ** -0.25
LN_EPS = 1e-5
RMS_EPS = 1e-6
NUM_BUCKETS = 32
REL_MAX_DIST = 2048
REL_HEADS = 4
GDN_HEADS = 6
GDN_DK = 128
GDN_DV = 128
GDN_CONV = 4
GDN_CHUNK = 64
GDN_QK = GDN_HEADS * GDN_DK
GDN_V = GDN_HEADS * GDN_DV
SWA_CONFIGS = ((128, 1), (512, 4), (2048, 16))
SWA_GROUPS = len(SWA_CONFIGS)
SWA_HEADS = 4
SWA_HEAD_DIM = 64
SWA_BLOCK = 128
SWA_QKV = SWA_GROUPS * SWA_HEADS * SWA_HEAD_DIM
SWA_OUT = SWA_HEADS * SWA_HEAD_DIM
DIFF_HEADS = 4
DIFF_HEAD_DIM = 64
DIFF_QK = DIFF_HEADS * 2 * DIFF_HEAD_DIM
DIFF_V = DIFF_HEADS * 2 * DIFF_HEAD_DIM
Q_BLOCK = 128
GLA_HEADS = 4
GLA_DK = 64
GLA_DV = 128
GLA_GATE_RANK = 16
GLA_GATE_TAU = 16.0
GLA_CHUNK = 64
GLA_QK = GLA_HEADS * GLA_DK
GLA_V = GLA_HEADS * GLA_DV
D_FF = 2816
FFN_CONV = 3

EVEN_SIZES = (GDN_QK, GDN_QK, GDN_V, GDN_V, GDN_HEADS, GDN_HEADS, SWA_QKV, SWA_QKV, SWA_QKV)
EVEN_IN = sum(EVEN_SIZES)
EVEN_SPLITS = tuple(int(v) for v in np.cumsum(EVEN_SIZES)[:-1])
EVEN_OUT = GDN_V + SWA_OUT
ODD_SIZES = (DIFF_QK, DIFF_QK, DIFF_V, GLA_QK, GLA_QK, GLA_V, GLA_V, GLA_GATE_RANK)
ODD_IN = sum(ODD_SIZES)
ODD_SPLITS = tuple(int(v) for v in np.cumsum(ODD_SIZES)[:-1])
ODD_OUT = DIFF_V + GLA_V
N_EVEN = (DEPTH + 1) // 2
N_ODD = DEPTH // 2

kernel_name = 'hybrid_gdn_dilated_diff_gla_trunk'


def layer_norm(x, g, b):
    xf = x.astype(jnp.float32)
    mu = jnp.mean(xf, -1, keepdims=True)
    var = jnp.mean(jnp.square(xf - mu), -1, keepdims=True)
    y = (xf - mu) * lax.rsqrt(var + LN_EPS) * g.astype(jnp.float32) + b.astype(jnp.float32)
    return y.astype(x.dtype)


def rms_norm(x, w):
    xf = x.astype(jnp.float32)
    return xf * lax.rsqrt(jnp.mean(xf * xf, -1, keepdims=True) + RMS_EPS) * w.astype(jnp.float32)


def l2_normalize(x):
    return x * lax.rsqrt(jnp.sum(x * x, -1, keepdims=True) + RMS_EPS)


def causal_depthwise_conv(x, w):
    width, seq = w.shape[0], x.shape[1]
    xp = jnp.pad(x, ((0, 0), (width - 1, 0), (0, 0)))
    y = w[0] * xp[:, :seq]
    for j in range(1, width):
        y = y + w[j] * xp[:, j:j + seq]
    return y


def rel_bucket(dist):
    max_exact = NUM_BUCKETS // 2
    d = jnp.maximum(dist, 1).astype(jnp.float32)
    large = max_exact + (jnp.log(d / max_exact) / math.log(REL_MAX_DIST / max_exact)
                         * (NUM_BUCKETS - max_exact)).astype(jnp.int32)
    large = jnp.minimum(large, NUM_BUCKETS - 1)
    return jnp.where(dist < max_exact, dist, large)


def gated_delta_rule(q, k, v, g, beta):
    bsz, seq, nh, dk = q.shape
    dv = v.shape[-1]
    c = GDN_CHUNK
    n = seq // c

    def chunk(t):
        return jnp.moveaxis(t.reshape((bsz, n, c, nh) + t.shape[3:]), 3, 1)

    qc, kc, vc, gc, bc = chunk(q), chunk(k), chunk(v), chunk(g), chunk(beta)
    gam = jnp.cumsum(gc, axis=-1)
    idx = jnp.arange(c)
    incl = idx[:, None] >= idx[None, :]
    strict = idx[:, None] > idx[None, :]
    decay = jnp.exp(jnp.where(incl, gam[..., :, None] - gam[..., None, :], -jnp.inf))
    kk = jnp.einsum('bhnid,bhnjd->bhnij', kc, kc)
    lower = jnp.eye(c, dtype=jnp.float32) + jnp.where(strict, bc[..., :, None] * kk * decay, 0.0)
    rhs = jnp.concatenate([vc * bc[..., None], kc * (bc * jnp.exp(gam))[..., None]], axis=-1)
    sol = lax.linalg.triangular_solve(lower, rhs, left_side=True, lower=True, unit_diagonal=True)
    u, w = sol[..., :dv], sol[..., dv:]
    qk = jnp.einsum('bhnid,bhnjd->bhnij', qc, kc) * decay
    q_dec = qc * jnp.exp(gam)[..., None]
    k_dec = kc * jnp.exp(gam[..., -1:] - gam)[..., None]
    g_last = jnp.exp(gam[..., -1])

    def step(state, inp):
        u_n, w_n, qk_n, qd_n, kd_n, gl_n = inp
        delta = u_n - jnp.einsum('bhck,bhkv->bhcv', w_n, state)
        o_n = jnp.einsum('bhck,bhkv->bhcv', qd_n, state) + jnp.einsum('bhij,bhjv->bhiv', qk_n, delta)
        state = gl_n[..., None, None] * state + jnp.einsum('bhck,bhcv->bhkv', kd_n, delta)
        return state, o_n

    xs = tuple(jnp.moveaxis(t, 2, 0) for t in (u, w, qk, q_dec, k_dec, g_last))
    state0 = jnp.zeros((bsz, nh, dk, dv), jnp.float32)
    _, o = lax.scan(step, state0, xs)
    return o.transpose(1, 0, 3, 2, 4).reshape(bsz, seq, nh, dv)


def dilated_branch(q, k, v, window, dilation, rel_bias):
    bsz, seq, nh, dh = q.shape
    span = window // dilation
    sub = seq // dilation
    nb = -(-sub // SWA_BLOCK)
    padded = nb * SWA_BLOCK

    def to_blocks(t):
        t = t.reshape(bsz, sub, dilation, nh, dh).transpose(0, 2, 1, 3, 4)
        t = jnp.pad(t, ((0, 0), (0, 0), (0, padded - sub), (0, 0), (0, 0)))
        return t.reshape(bsz, dilation, nb, SWA_BLOCK, nh, dh)

    def with_prev(t):
        prev = jnp.pad(t, ((0, 0), (0, 0), (1, 0), (0, 0), (0, 0), (0, 0)))[:, :, :-1]
        return jnp.concatenate([prev, t], axis=3)

    qb = to_blocks(q)
    kb, vb = with_prev(to_blocks(k)), with_prev(to_blocks(v))
    qi = jnp.arange(SWA_BLOCK)[:, None] + SWA_BLOCK
    kj = jnp.arange(2 * SWA_BLOCK)[None, :]
    rel = qi - kj
    key_sub = jnp.arange(nb)[:, None, None] * SWA_BLOCK + kj[None] - SWA_BLOCK
    mask = (rel >= 0) & (rel <= span) & (key_sub >= 0)
    bias = jnp.moveaxis(rel_bias[rel_bucket(jnp.maximum(rel, 0) * dilation)], -1, 0)
    s = jnp.einsum('bgnqhd,bgnkhd->bgnhqk', qb, kb).astype(jnp.float32) * dh ** -0.5
    s = s + bias.astype(jnp.float32)
    s = jnp.where(mask[None, None, :, None], s, -jnp.inf)
    m = jnp.max(s, axis=-1, keepdims=True)
    p = jnp.exp(s - m)
    l = jnp.sum(p, axis=-1, keepdims=True)
    o = jnp.einsum('bgnhqk,bgnkhd->bgnqhd', (p / l).astype(v.dtype), vb)
    lse = (m + jnp.log(l))[..., 0]
    o = o.reshape(bsz, dilation, padded, nh, dh)[:, :, :sub]
    o = o.transpose(0, 2, 1, 3, 4).reshape(bsz, seq, nh, dh)
    lse = lse.transpose(0, 1, 2, 4, 3).reshape(bsz, dilation, padded, nh)[:, :, :sub]
    lse = lse.transpose(0, 2, 1, 3).reshape(bsz, seq, nh)
    return o, lse


def dilated_attention(q, k, v, rel_bias):
    bsz, seq = q.shape[0], q.shape[1]
    outs, lses = [], []
    for g, (window, dilation) in enumerate(SWA_CONFIGS):
        o, lse = dilated_branch(q[:, :, g], k[:, :, g], v[:, :, g], window, dilation, rel_bias)
        outs.append(o)
        lses.append(lse)
    wts = jax.nn.softmax(jnp.stack(lses, 0), axis=0)
    o = jnp.einsum('gbsh,gbshd->bshd', wts, jnp.stack(outs, 0).astype(jnp.float32))
    return o.reshape(bsz, seq, SWA_OUT)


def even_mixer(x, rel_bias, w_in, conv_w, a_log, dt_bias, norm_w, w_out):
    bsz, seq, _ = x.shape
    f32 = jnp.float32
    q_a, k_a, v_a, z_a, b_a, a_a, q_b, k_b, v_b = jnp.split(x @ w_in, EVEN_SPLITS, axis=-1)
    qkv = jax.nn.silu(causal_depthwise_conv(jnp.concatenate([q_a, k_a, v_a], -1), conv_w)).astype(f32)
    q_a, k_a, v_a = jnp.split(qkv, (GDN_QK, 2 * GDN_QK), axis=-1)
    hk = (bsz, seq, GDN_HEADS, GDN_DK)
    q_a = l2_normalize(q_a.reshape(hk)) * GDN_DK ** -0.5
    k_a = l2_normalize(k_a.reshape(hk))
    v_a = v_a.reshape(bsz, seq, GDN_HEADS, GDN_DV)
    beta = jax.nn.sigmoid(b_a.astype(f32))
    g = -jnp.exp(a_log.astype(f32)) * jax.nn.softplus(a_a.astype(f32) + dt_bias.astype(f32))
    o_a = gated_delta_rule(q_a, k_a, v_a, g, beta)
    o_a = rms_norm(o_a, norm_w) * jax.nn.silu(z_a.astype(f32).reshape(bsz, seq, GDN_HEADS, GDN_DV))
    o_a = o_a.reshape(bsz, seq, GDN_V).astype(x.dtype)
    shp = (bsz, seq, SWA_GROUPS, SWA_HEADS, SWA_HEAD_DIM)
    o_b = dilated_attention(q_b.reshape(shp), k_b.reshape(shp), v_b.reshape(shp), rel_bias).astype(x.dtype)
    return jnp.concatenate([o_a, o_b], axis=-1) @ w_out


def diff_attention(q, k, v, lam, rel_bias):
    bsz, seq, nh, _, dh = q.shape
    nq = seq // Q_BLOCK
    qb = q.reshape(bsz, nq, Q_BLOCK, nh, 2, dh).transpose(1, 0, 3, 4, 2, 5)
    kt = k.transpose(0, 2, 3, 1, 4)
    vt = v.transpose(0, 2, 1, 3)
    k_pos = jnp.arange(seq)

    def block(args):
        q_blk, start = args
        dist = (start + jnp.arange(Q_BLOCK))[:, None] - k_pos[None, :]
        bias = jnp.moveaxis(rel_bias[rel_bucket(jnp.maximum(dist, 0))], -1, 0).astype(jnp.float32)
        s = jnp.einsum('bhcqd,bhckd->bhcqk', q_blk, kt).astype(jnp.float32) * dh ** -0.5
        s = jnp.where(dist >= 0, s + bias[None, :, None], -jnp.inf)
        p = jax.nn.softmax(s, axis=-1)
        attn = p[:, :, 0] - lam * p[:, :, 1]
        return jnp.einsum('bhqk,bhkv->bhqv', attn.astype(v.dtype), vt)

    o = lax.map(block, (qb, jnp.arange(nq) * Q_BLOCK))
    return o.transpose(1, 0, 3, 2, 4).reshape(bsz, seq, nh, 2 * dh)


def gla_chunked(q, k, v, log_a):
    bsz, seq, nh, dk = q.shape
    dv = v.shape[-1]
    c = GLA_CHUNK
    n = seq // c

    def chunk(t):
        return t.reshape(bsz, n, c, nh, t.shape[-1]).transpose(1, 0, 3, 2, 4)

    qc, kc, vc = chunk(q), chunk(k), chunk(v)
    bc = jnp.cumsum(chunk(log_a), axis=3)
    idx = jnp.arange(c)
    incl = (idx[:, None] >= idx[None, :])[:, :, None]

    def step(state, inp):
        q_n, k_n, v_n, b_n = inp
        dec = jnp.exp(jnp.where(incl, b_n[..., :, None, :] - b_n[..., None, :, :], -jnp.inf))
        attn = jnp.einsum('bhik,bhjk,bhijk->bhij', q_n, k_n, dec)
        o_n = jnp.einsum('bhik,bhkv->bhiv', q_n * jnp.exp(b_n), state) + jnp.einsum('bhij,bhjv->bhiv', attn, v_n)
        b_last = b_n[..., -1:, :]
        state = jnp.exp(b_last[..., 0, :])[..., None] * state + jnp.einsum(
            'bhck,bhcv->bhkv', k_n * jnp.exp(b_last - b_n), v_n)
        return state, o_n

    state0 = jnp.zeros((bsz, nh, dk, dv), jnp.float32)
    _, o = lax.scan(step, state0, (qc, kc, vc, bc))
    return o.transpose(1, 0, 3, 2, 4).reshape(bsz, seq, nh, dv)


def odd_mixer(x, rel_bias, w_in, lam_params, diff_norm_w, gla_w_gate, gla_b_gate, gla_norm_w, w_out, lam_init):
    bsz, seq, _ = x.shape
    f32 = jnp.float32
    q_c, k_c, v_c, q_d, k_d, v_d, r_d, g_d = jnp.split(x @ w_in, ODD_SPLITS, axis=-1)
    lp = lam_params.astype(f32)
    lam = jnp.exp(jnp.sum(lp[0] * lp[1])) - jnp.exp(jnp.sum(lp[2] * lp[3])) + lam_init
    shp = (bsz, seq, DIFF_HEADS, 2, DIFF_HEAD_DIM)
    o_c = diff_attention(q_c.reshape(shp), k_c.reshape(shp),
                         v_c.reshape(bsz, seq, DIFF_HEADS, 2 * DIFF_HEAD_DIM), lam, rel_bias)
    o_c = (rms_norm(o_c, diff_norm_w) * (1.0 - lam_init)).reshape(bsz, seq, DIFF_V).astype(x.dtype)
    log_a = jax.nn.log_sigmoid((g_d @ gla_w_gate + gla_b_gate).astype(f32)) / GLA_GATE_TAU
    hk = (bsz, seq, GLA_HEADS, GLA_DK)
    o_d = gla_chunked(q_d.astype(f32).reshape(hk) * GLA_DK ** -0.5, k_d.astype(f32).reshape(hk),
                      v_d.astype(f32).reshape(bsz, seq, GLA_HEADS, GLA_DV), log_a.reshape(hk))
    o_d = rms_norm(o_d, gla_norm_w) * jax.nn.silu(r_d.astype(f32).reshape(bsz, seq, GLA_HEADS, GLA_DV))
    o_d = o_d.reshape(bsz, seq, GLA_V).astype(x.dtype)
    return jnp.concatenate([o_c, o_d], axis=-1) @ w_out


def conv_ffn(x, w_up, conv_w, conv_b, w_down):
    h = causal_depthwise_conv(x @ w_up, conv_w) + conv_b
    gate, val = jnp.split(h, 2, axis=-1)
    return (jax.nn.silu(gate) * val) @ w_down


def setup_inputs(seed: int = 0) -> dict:
    key = jax.random.key(seed)
    ks = jax.random.split(key, 24)
    f32 = jnp.float32

    def normal(k, shape, scale):
        return jax.random.normal(k, shape, f32) * scale

    dt = jnp.exp(jax.random.uniform(ks[5], (N_EVEN, GDN_HEADS), f32, math.log(1e-3), math.log(1e-1)))
    return {
        'x': normal(ks[0], (BATCH, SEQ, D_MODEL), 1.0),
        'rel_bias': normal(ks[1], (NUM_BUCKETS, REL_HEADS), 0.1),
        'w_in_even': normal(ks[2], (N_EVEN, D_MODEL, EVEN_IN), D_MODEL ** -0.5),
        'gdn_conv_w': normal(ks[3], (N_EVEN, GDN_CONV, 2 * GDN_QK + GDN_V), GDN_CONV ** -0.5),
        'gdn_a_log': jnp.log(jax.random.uniform(ks[4], (N_EVEN, GDN_HEADS), f32, 1.0, 16.0)),
        'gdn_dt_bias': dt + jnp.log(-jnp.expm1(-dt)),
        'gdn_norm_w': 1.0 + normal(ks[6], (N_EVEN, GDN_DV), 0.05),
        'w_out_even': normal(ks[7], (N_EVEN, EVEN_OUT, D_MODEL), EVEN_OUT ** -0.5 * DEEPNORM_BETA),
        'w_in_odd': normal(ks[8], (N_ODD, D_MODEL, ODD_IN), D_MODEL ** -0.5),
        'diff_lambda': normal(ks[9], (N_ODD, 4, DIFF_HEAD_DIM), 0.1),
        'diff_norm_w': 1.0 + normal(ks[10], (N_ODD, 2 * DIFF_HEAD_DIM), 0.05),
        'gla_w_gate': normal(ks[11], (N_ODD, GLA_GATE_RANK, GLA_QK), GLA_GATE_RANK ** -0.5),
        'gla_b_gate': normal(ks[12], (N_ODD, GLA_QK), 0.1),
        'gla_norm_w': 1.0 + normal(ks[13], (N_ODD, GLA_DV), 0.05),
        'w_out_odd': normal(ks[14], (N_ODD, ODD_OUT, D_MODEL), ODD_OUT ** -0.5 * DEEPNORM_BETA),
        'ffn_w_up': normal(ks[15], (DEPTH, D_MODEL, 2 * D_FF), D_MODEL ** -0.5),
        'ffn_conv_w': normal(ks[16], (DEPTH, FFN_CONV, 2 * D_FF), FFN_CONV ** -0.5),
        'ffn_conv_b': normal(ks[17], (DEPTH, 2 * D_FF), 0.02),
        'ffn_w_down': normal(ks[18], (DEPTH, D_FF, D_MODEL), D_FF ** -0.5 * DEEPNORM_BETA),
        'ln_g': 1.0 + normal(ks[19], (DEPTH, 2, D_MODEL), 0.05),
        'ln_b': normal(ks[20], (DEPTH, 2, D_MODEL), 0.02),
    }


def reference(x, rel_bias, w_in_even, gdn_conv_w, gdn_a_log, gdn_dt_bias, gdn_norm_w, w_out_even,
              w_in_odd, diff_lambda, diff_norm_w, gla_w_gate, gla_b_gate, gla_norm_w, w_out_odd,
              ffn_w_up, ffn_conv_w, ffn_conv_b, ffn_w_down, ln_g, ln_b):
    h = x
    for layer in range(DEPTH):
        i = layer // 2
        if layer % 2 == 0:
            mix = even_mixer(h, rel_bias, w_in_even[i], gdn_conv_w[i], gdn_a_log[i], gdn_dt_bias[i],
                             gdn_norm_w[i], w_out_even[i])
        else:
            lam_init = 0.8 - 0.6 * math.exp(-0.3 * layer)
            mix = odd_mixer(h, rel_bias, w_in_odd[i], diff_lambda[i], diff_norm_w[i], gla_w_gate[i],
                            gla_b_gate[i], gla_norm_w[i], w_out_odd[i], lam_init)
        h = layer_norm(DEEPNORM_ALPHA * h + mix, ln_g[layer, 0], ln_b[layer, 0])
        ffn = conv_ffn(h, ffn_w_up[layer], ffn_conv_w[layer], ffn_conv_b[layer], ffn_w_down[layer])
        h = layer_norm(DEEPNORM_ALPHA * h + ffn, ln_g[layer, 1], ln_b[layer, 1])
    return h
```

```cpp
#define MULTI_LAUNCH 1
#include <hip/hip_runtime.h>
#include <hip/hip_cooperative_groups.h>
#include <cstdio>
#include <cstdint>
namespace cg = cooperative_groups;

extern __shared__ __attribute__((aligned(16))) unsigned char g_shm[];
namespace pg8 {
#define PG8_LAS __attribute__((address_space(3)))
typedef unsigned short bf16_t;
typedef short bf16x8 __attribute__((ext_vector_type(8)));
typedef float f32x4 __attribute__((ext_vector_type(4)));
typedef unsigned u32x4 __attribute__((ext_vector_type(4)));
constexpr int BM = 256, BK = 64, HALF = 128, HTB = HALF * BK * 2  , STAGE_BYTES = 8 * HTB, NXCD = 8, WGM = 8;

__host__ __device__ __forceinline__ int lds_byte(int r, int c) { const int st = (r >> 4) * 2 + (c >> 5), rr = r & 15, cc = c & 31, ob = rr * 64 + cc * 2; return st * 1024 + (ob ^ (((ob >> 9) & 1) << 5)); }
__host__ __device__ __forceinline__ void stage_rc(int b, int& R, int& C) { const int st = b / 1024, sb = b % 1024, swz = sb ^ (((sb >> 9) & 1) << 5); R = (st >> 1) * 16 + swz / 64; C = (st & 1) * 32 + (swz % 64) / 2; }
__host__ __device__ __forceinline__ int perm32(int rho) { const int n = rho >> 4, i = rho & 15; return 8 * (i >> 2) + 4 * n + (i & 3); }
struct Unit { int pm, pn; };
struct Gemm { const bf16_t* A; const bf16_t* Bt; int M, N, K, lda; };

struct StaticOrder {
    int nM, nN, nwg, G, c;
    __host__ __device__ void init(int M, int N, int G_, int c_) { nM = M / BM; nN = N / BM; nwg = nM * nN; G = G_; c = c_; }
    __host__ __device__ bool next(int i, Unit& u) const {
        const long L = (long)i * G + c; if (L >= nwg) return false;
        int wgid = (int)L; { const int q = nwg / NXCD, r = nwg % NXCD, xcd = wgid % NXCD, off = wgid / NXCD; wgid = (xcd < r ? xcd * (q + 1) : r * (q + 1) + (xcd - r) * q) + off; }
        const int nig = WGM * nN, gid = wgid / nig, fm = gid * WGM, gsz = (nM - fm) < WGM ? (nM - fm) : WGM;
        u.pm = fm + ((wgid % nig) % gsz); u.pn = (wgid % nig) / gsz; return true;
    }
    __device__ __forceinline__ void a_ready(const Unit&) const {}
    __device__ __forceinline__ void done(const Unit&) const {}
};
template <class Epi, class Sched, bool STAMP = false>
__device__ __forceinline__ void gemm_phase(PG8_LAS unsigned char* lds, const Gemm g, const Sched& S, const Epi& E, unsigned long long* stamps) {
    const int tid = threadIdx.x, wid = __builtin_amdgcn_readfirstlane(tid >> 6), lane = tid & 63, wr = wid >> 2, wc = wid & 3, fr = lane & 15, fq = lane >> 4;
    const int K = g.K, nt = K / BK;
    int ts_lo = 0, ts_hi = 0, nts = 0; const unsigned long long rt_entry = STAMP ? (unsigned long long)0 : 0ull;
#define PG8_STAMP() do { if (STAMP && wid == 0 && nts < 64) { const unsigned long long _c = (unsigned long long)clock64(); \
        ts_lo = (lane == nts) ? (int)(unsigned)_c : ts_lo; ts_hi = (lane == nts) ? (int)(unsigned)(_c >> 32) : ts_hi; ++nts; } } while (0)
    PG8_STAMP();
    unsigned voffA[2], voffB[2];
#pragma unroll
    for (int i = 0; i < 2; ++i) { int R, C; stage_rc(tid * 16 + i * 8192, R, C); const int Rb = Epi::PERM ? ((R & ~31) + perm32(R & 31)) : R;
        voffA[i] = (unsigned)(R * g.lda + C) * 2u; voffB[i] = (unsigned)(Rb * K + C) * 2u; }
    const size_t kstep = (size_t)(BK * 2);
    const size_t hstep = (size_t)HALF * K * 2, hstepA = (size_t)HALF * g.lda * 2;
    const size_t tstep = 2 * hstep, tstepA = 2 * hstepA;
    const unsigned ldsw = (unsigned)wid * 1024u;
    const int aoff = lds_byte(wr * 64 + fr, fq * 8), boff = lds_byte(wc * 32 + fr, fq * 8);
#define PG8_SA(b, h) (((b) * 2 + (h)) * HTB)
#define PG8_SB(b, h) ((4 + (b) * 2 + (h)) * HTB)
#define PG8_STAGE(bufoff, gbase, voff) do { _Pragma("unroll") for (int _i = 0; _i < 2; ++_i) \
        __builtin_amdgcn_global_load_lds((const unsigned*)((const char*)(gbase) + (voff)[_i]), (PG8_LAS unsigned*)(lds + (bufoff) + ldsw + _i * 8192), 16, 0, 0); } while (0)
#define PG8_LDA(dst, b, h) do { _Pragma("unroll") for (int m = 0; m < 4; ++m) _Pragma("unroll") for (int k = 0; k < 2; ++k) dst[m][k] = *(const PG8_LAS bf16x8*)(lds + PG8_SA(b, h) + aoff + m * 2048 + k * 1024); } while (0)
#define PG8_LDB(dst, b, h) do { _Pragma("unroll") for (int n = 0; n < 2; ++n) _Pragma("unroll") for (int k = 0; k < 2; ++k) dst[n][k] = *(const PG8_LAS bf16x8*)(lds + PG8_SB(b, h) + boff + n * 2048 + k * 1024); } while (0)
#define PG8_MMA(ai, bj, At, Bt) do { __builtin_amdgcn_s_setprio(1); _Pragma("unroll") for (int m = 0; m < 4; ++m) _Pragma("unroll") for (int n = 0; n < 2; ++n) _Pragma("unroll") for (int k = 0; k < 2; ++k) \
        acc[ai][bj][m][n] = __builtin_amdgcn_mfma_f32_16x16x32_bf16(Bt[n][k], At[m][k], acc[ai][bj][m][n], 0, 0, 0); __builtin_amdgcn_s_setprio(0); } while (0)
#define PG8_WAIT_V(n) asm volatile("s_waitcnt vmcnt(" #n ")" ::: "memory")
#define PG8_WAIT_L(n) asm volatile("s_waitcnt lgkmcnt(" #n ")" ::: "memory")
#define PG8_BAR __builtin_amdgcn_s_barrier()
#define PG8_SCHED __builtin_amdgcn_sched_barrier(0)
    Unit cur, nxt; int ui = 0;
    if (!S.next(0, cur)) return;
    f32x4 acc[2][2][4][2];
#pragma unroll
    for (int a = 0; a < 2; ++a)
#pragma unroll
        for (int b = 0; b < 2; ++b)
#pragma unroll
            for (int m = 0; m < 4; ++m)
#pragma unroll
                for (int n = 0; n < 2; ++n) acc[a][b][m][n] = (f32x4){0.f, 0.f, 0.f, 0.f};
    bf16x8 At[4][2], B0[2][2], B1[2][2];
    const char* cA = (const char*)g.A + (size_t)cur.pm * tstepA; const char* cB = (const char*)g.Bt + (size_t)cur.pn * tstep;
    S.a_ready(cur);
    PG8_STAGE(PG8_SB(0, 0), cB, voffB); PG8_STAGE(PG8_SA(0, 0), cA, voffA); PG8_STAGE(PG8_SB(0, 1), cB + hstep, voffB); PG8_STAGE(PG8_SA(0, 1), cA + hstepA, voffA);
    if (wr == 1) PG8_BAR;
    PG8_WAIT_V(4); PG8_BAR;
    PG8_STAGE(PG8_SB(1, 0), cB + kstep, voffB); PG8_STAGE(PG8_SA(1, 0), cA + kstep, voffA); PG8_STAGE(PG8_SB(1, 1), cB + hstep + kstep, voffB);
    PG8_WAIT_V(6); PG8_BAR;
    PG8_STAMP();
    for (;;) {
        const bool has_next = S.next(ui + 1, nxt);
        const char* nA = has_next ? (const char*)g.A + (size_t)nxt.pm * tstepA : cA; const char* nB = has_next ? (const char*)g.Bt + (size_t)nxt.pn * tstep : cB;
        for (int t = 0; t < nt; t += 2) {
            const bool last = (t == nt - 2);
            const char* a1 = cA + (size_t)(t + 1) * kstep;
            const char* a2 = last ? nA : cA + (size_t)(t + 2) * kstep; const char* b2 = last ? nB : cB + (size_t)(t + 2) * kstep;
            const char* a3 = a2 + kstep; const char* b3 = b2 + kstep;
            if (last && has_next) S.a_ready(nxt);
            PG8_LDB(B0, 0, 0); PG8_SCHED; PG8_LDA(At, 0, 0); PG8_STAGE(PG8_SA(1, 1), a1 + hstepA, voffA);
            PG8_WAIT_L(8); PG8_BAR; PG8_WAIT_L(0); PG8_MMA(0, 0, At, B0); PG8_BAR; PG8_SCHED;
            PG8_LDB(B1, 0, 1); PG8_STAGE(PG8_SB(0, 0), b2, voffB);
            PG8_BAR; PG8_WAIT_L(0); PG8_MMA(0, 1, At, B1); PG8_BAR;
            PG8_LDA(At, 0, 1); PG8_STAGE(PG8_SA(0, 0), a2, voffA);
            PG8_BAR; PG8_WAIT_L(0); PG8_MMA(1, 0, At, B0); PG8_BAR; PG8_SCHED;
            PG8_STAGE(PG8_SB(0, 1), b2 + hstep, voffB);
            PG8_WAIT_V(6); PG8_BAR; PG8_MMA(1, 1, At, B1); PG8_BAR;
            PG8_LDB(B0, 1, 0); PG8_SCHED; PG8_LDA(At, 1, 0); PG8_STAGE(PG8_SA(0, 1), a2 + hstepA, voffA);
            PG8_WAIT_L(8); PG8_BAR; PG8_WAIT_L(0); PG8_MMA(0, 0, At, B0); PG8_BAR; PG8_SCHED;
            PG8_LDB(B1, 1, 1); PG8_STAGE(PG8_SB(1, 0), b3, voffB);
            PG8_BAR; PG8_WAIT_L(0); PG8_MMA(0, 1, At, B1); PG8_BAR;
            PG8_LDA(At, 1, 1); PG8_STAGE(PG8_SA(1, 0), a3, voffA);
            PG8_BAR; PG8_WAIT_L(0); PG8_MMA(1, 0, At, B0); PG8_BAR; PG8_SCHED;
            PG8_STAGE(PG8_SB(1, 1), b3 + hstep, voffB);
            PG8_WAIT_V(6); PG8_BAR; PG8_MMA(1, 1, At, B1); PG8_BAR;
        }
        PG8_STAMP();
        if constexpr (!Epi::AFTER_DRAIN) { E(acc, cur, wr, wc, fr, fq); S.done(cur); }
        PG8_STAMP();
        if (!has_next) break;
#pragma unroll
        for (int a = 0; a < 2; ++a)
#pragma unroll
            for (int b = 0; b < 2; ++b)
#pragma unroll
                for (int m = 0; m < 4; ++m)
#pragma unroll
                    for (int n = 0; n < 2; ++n) acc[a][b][m][n] = (f32x4){0.f, 0.f, 0.f, 0.f};
        cur = nxt; cA = nA; cB = nB; ++ui;
    }
    PG8_WAIT_V(0);
    if (wr == 0) PG8_BAR;
    PG8_BAR;
    if constexpr (Epi::AFTER_DRAIN) { E.fused(acc, cur, wr, wc, fr, fq, lds, wid, lane); S.done(cur); }
    PG8_STAMP();
    if (STAMP && wid == 0) { stamps[lane] = lane < nts ? (((unsigned long long)(unsigned)ts_hi << 32) | (unsigned)ts_lo) : 0ull;
        if (lane == 62) stamps[62] = rt_entry; if (lane == 63) stamps[63] = (unsigned long long)0; }
#undef PG8_STAMP
#undef PG8_SA
#undef PG8_SB
#undef PG8_STAGE
#undef PG8_LDA
#undef PG8_LDB
#undef PG8_MMA
#undef PG8_WAIT_V
#undef PG8_WAIT_L
#undef PG8_BAR
#undef PG8_SCHED
}
}

typedef unsigned short bf16_t;
typedef short bf16x8 __attribute__((ext_vector_type(8)));
typedef float f32x4 __attribute__((ext_vector_type(4)));
typedef unsigned u32x4 __attribute__((ext_vector_type(4)));
typedef unsigned u32x2 __attribute__((ext_vector_type(2)));
#define DEV __device__ __forceinline__

constexpr int MTOK = 32768, DM = 1024, SEQ = 8192;
constexpr int LDE = 5376, LDO = 3072, LDF = 5632;
constexpr size_t MiB = (size_t)1 << 20;
constexpr size_t OFF_P = 0, OFF_HB = 352 * MiB, OFF_WT = 416 * MiB;
constexpr size_t W_INE = 0, W_OUTE = W_INE + (size_t)5376 * 1024, W_INO = W_OUTE + (size_t)1024 * 1024, W_OUTO = W_INO + (size_t)3072 * 1024,
                 W_UP0 = W_OUTO + (size_t)1024 * 1024, W_UP1 = W_UP0 + (size_t)5632 * 1024, W_DN0 = W_UP1 + (size_t)5632 * 1024, W_DN1 = W_DN0 + (size_t)1024 * 2816;
constexpr size_t OFF_THIN = 470 * MiB, OFF_HALO1 = OFF_THIN + 2 * MiB, OFF_HALO2 = OFF_HALO1 + 7 * MiB, OFF_GAM = OFF_HALO2 + 6 * MiB, OFF_BETA = OFF_GAM + MiB,
                 OFF_LSE = OFF_BETA + MiB, OFF_BLUT = OFF_LSE + 2 * MiB, OFF_CNT = OFF_BLUT + 32768, OFF_LAM = OFF_CNT + 256, WS_NEED = OFF_LAM + 256;
constexpr float DN_ALPHA = 1.4142135623730951f;
constexpr float LAM_INIT = 0.35550906759f;
constexpr float LOG2E = 1.4426950408889634f;
constexpr int NLUT = 1536;

struct Params {
    const float *x, *rel_bias, *w_in_even, *gdn_conv_w, *gdn_a_log, *gdn_dt_bias, *gdn_norm_w, *w_out_even, *w_in_odd, *diff_lambda, *diff_norm_w, *gla_w_gate,
        *gla_b_gate, *gla_norm_w, *w_out_odd, *ffn_w_up, *ffn_conv_w, *ffn_conv_b, *ffn_w_down, *ln_g, *ln_b;
    float* out; unsigned char* ws;
};

DEV float lo2f(unsigned w) { return __uint_as_float(w << 16); }
DEV float hi2f(unsigned w) { return __uint_as_float(w & 0xffff0000u); }
DEV float bf2f(bf16_t b) { return __uint_as_float(((unsigned)b) << 16); }
typedef __bf16 bf16v2_t __attribute__((ext_vector_type(2)));
typedef float f32v2_t __attribute__((ext_vector_type(2)));
DEV unsigned pk2(float lo, float hi) { const f32v2_t v = {lo, hi}; const bf16v2_t b = __builtin_convertvector(v, bf16v2_t); return __builtin_bit_cast(unsigned, b); }
DEV bf16_t f2bf(float f) { return (bf16_t)(pk2(f, 0.f) & 0xffffu); }
DEV bf16x8 mk8(unsigned a, unsigned b, unsigned c, unsigned d) { u32x4 v = {a, b, c, d}; return __builtin_bit_cast(bf16x8, v); }
DEV f32x4 mfma16(bf16x8 a, bf16x8 b, f32x4 c) { return __builtin_amdgcn_mfma_f32_16x16x32_bf16(a, b, c, 0, 0, 0); }
DEV bf16x8 ld8(const bf16_t* p) { return *(const bf16x8*)p; }
DEV bf16x8 ldperm(const bf16_t* p) { const u32x2 lo = *(const u32x2*)p, hi = *(const u32x2*)(p + 16); return mk8(lo.x, lo.y, hi.x, hi.y); }
DEV bf16x8 pk8(f32x4 a, f32x4 b) { return mk8(pk2(a[0], a[1]), pk2(a[2], a[3]), pk2(b[0], b[1]), pk2(b[2], b[3])); }
DEV float silu(float x) { return x / (1.0f + __expf(-x)); }
DEV float wsum(float v) { for (int o = 32; o >= 1; o >>= 1) v += __shfl_xor(v, o); return v; }
DEV float ex2(float x) { return __builtin_amdgcn_exp2f(x); }

struct EpiStoreBf16 {
    static constexpr bool PERM = true, AFTER_DRAIN = false;
    bf16_t* O; int ldc; bf16_t* halo; int seg, hrows, hcols;
    __device__ __forceinline__ void operator()(const f32x4 (&acc)[2][2][4][2], const pg8::Unit& u, int wr, int wc, int fr, int fq) const {
        const int row0 = u.pm * 256 + wr * 64 + fr, col0 = u.pn * 256 + wc * 32 + 8 * fq;
#pragma unroll
        for (int ai = 0; ai < 2; ++ai)
#pragma unroll
            for (int m = 0; m < 4; ++m) {
                const int row = row0 + ai * 128 + m * 16; bf16_t* rowp = O + (size_t)row * ldc + col0;
                const int rs = row & (seg - 1); const bool hal = rs >= seg - hrows;
#pragma unroll
                for (int bj = 0; bj < 2; ++bj) {
                    const f32x4 v0 = acc[ai][bj][m][0], v1 = acc[ai][bj][m][1];
                    u32x4 w; w.x = pk2(v0[0], v0[1]); w.y = pk2(v0[2], v0[3]); w.z = pk2(v1[0], v1[1]); w.w = pk2(v1[2], v1[3]);
                    *(u32x4*)(rowp + bj * 128) = w;
                    if (hal && col0 + bj * 128 < hcols) *(u32x4*)(halo + ((size_t)(row / seg) * hrows + (rs - (seg - hrows))) * hcols + col0 + bj * 128) = w;
                }
            }
    }
};
struct EpiResF32 {
    static constexpr bool PERM = false, AFTER_DRAIN = false;
    const float* base; float* out; int ldc; float alpha;
    __device__ __forceinline__ void operator()(const f32x4 (&acc)[2][2][4][2], const pg8::Unit& u, int wr, int wc, int fr, int fq) const {
        const int row0 = u.pm * 256 + wr * 64 + fr, col0 = u.pn * 256 + wc * 32 + 4 * fq;
#pragma unroll
        for (int ai = 0; ai < 2; ++ai)
#pragma unroll
            for (int m = 0; m < 4; ++m) {
                const size_t off = (size_t)(row0 + ai * 128 + m * 16) * ldc + col0;
#pragma unroll
                for (int bj = 0; bj < 2; ++bj)
#pragma unroll
                    for (int n = 0; n < 2; ++n) { const f32x4 bs = *(const f32x4*)(base + off + bj * 128 + n * 16); *(f32x4*)(out + off + bj * 128 + n * 16) = bs * alpha + acc[ai][bj][m][n]; }
                asm volatile("" ::: "memory");
            }
    }
};
template <class Epi> DEV void run_gemm(const bf16_t* A, int lda, const bf16_t* Bt, int M, int N, int K, const Epi& E) {
    pg8::Gemm g; g.A = A; g.Bt = Bt; g.M = M; g.N = N; g.K = K; g.lda = lda;
    pg8::StaticOrder S; S.init(M, N, (int)gridDim.x, (int)blockIdx.x);
    pg8::gemm_phase<Epi, pg8::StaticOrder, false>((PG8_LAS unsigned char*)g_shm, g, S, E, nullptr);
}

DEV void cvt_tile(const float* src, int ld, int K, int srcn0, int k0, bf16_t* dst, int dstn0) {
    float* tile = (float*)g_shm; const int tid = threadIdx.x;
#pragma unroll
    for (int i = 0; i < 2; ++i) { const int idx = tid + 512 * i, kk = idx >> 4, n4 = (idx & 15) * 4; const float4 v = *(const float4*)(src + (size_t)(k0 + kk) * ld + srcn0 + n4);
        tile[kk * 65 + n4] = v.x; tile[kk * 65 + n4 + 1] = v.y; tile[kk * 65 + n4 + 2] = v.z; tile[kk * 65 + n4 + 3] = v.w; }
    __syncthreads();
    { const int n = tid >> 3, k8 = (tid & 7) * 8; float v[8];
#pragma unroll
      for (int j = 0; j < 8; ++j) v[j] = tile[(k8 + j) * 65 + n];
      u32x4 w; w.x = pk2(v[0], v[1]); w.y = pk2(v[2], v[3]); w.z = pk2(v[4], v[5]); w.w = pk2(v[6], v[7]);
      *(u32x4*)(dst + (size_t)(dstn0 + n) * K + k0 + k8) = w; }
    __syncthreads();
}
DEV void phase_weights(const Params& p) {
    bf16_t* WT = (bf16_t*)(p.ws + OFF_WT);
#pragma unroll 1
    for (int t = blockIdx.x; t < 6848; t += gridDim.x) {
        const float* src; int ld, K, nt; bf16_t* dst; int shift = 0; int lt = t;
        if (lt < 1344) { src = p.w_in_even; ld = 5388; K = 1024; nt = 84; dst = WT + W_INE; shift = 12; }
        else if ((lt -= 1344) < 256) { src = p.w_out_even; ld = 1024; K = 1024; nt = 16; dst = WT + W_OUTE; }
        else if ((lt -= 256) < 768) { src = p.w_in_odd; ld = 3088; K = 1024; nt = 48; dst = WT + W_INO; }
        else if ((lt -= 768) < 256) { src = p.w_out_odd; ld = 1024; K = 1024; nt = 16; dst = WT + W_OUTO; }
        else if ((lt -= 256) < 1408) { src = p.ffn_w_up; ld = 5632; K = 1024; nt = 88; dst = WT + W_UP0; }
        else if ((lt -= 1408) < 1408) { src = p.ffn_w_up + (size_t)1024 * 5632; ld = 5632; K = 1024; nt = 88; dst = WT + W_UP1; }
        else if ((lt -= 1408) < 704) { src = p.ffn_w_down; ld = 1024; K = 2816; nt = 16; dst = WT + W_DN0; }
        else { lt -= 704; src = p.ffn_w_down + (size_t)2816 * 1024; ld = 1024; K = 2816; nt = 16; dst = WT + W_DN1; }
        const int ntile = lt % nt, ktile = lt / nt; const int n0 = ntile * 64; const int srcn0 = (n0 >= 3072) ? n0 + shift : n0;
        cvt_tile(src, ld, K, srcn0, ktile * 64, dst, n0);
    }
    if (blockIdx.x == 0) {
        float* blut = (float*)(p.ws + OFF_BLUT);
        for (int d = threadIdx.x; d < NLUT; d += 512) {
            int bk;
            if (d < 16) bk = d; else { const float lg = logf((float)d / 16.0f) / 4.852030263919617f * 16.0f; bk = 16 + (int)lg; if (bk > 31) bk = 31; }
            for (int h = 0; h < 4; ++h) blut[h * NLUT + d] = p.rel_bias[bk * 4 + h];
        }
        if (threadIdx.x == 0) {
            float s1 = 0.f, s2 = 0.f; for (int i = 0; i < 64; ++i) { s1 += p.diff_lambda[i] * p.diff_lambda[64 + i]; s2 += p.diff_lambda[128 + i] * p.diff_lambda[192 + i]; }
            *(float*)(p.ws + OFF_LAM) = expf(s1) - expf(s2) + LAM_INIT;
            *(unsigned*)(p.ws + OFF_CNT) = 0u;
        }
    }
}

DEV void rowpass(const float* src, float* dst, bf16_t* hb, const float* lg, const float* lb, const float* wthin, int ldw, int nc, float* thin) {
    float* W = (float*)g_shm; const int tid = threadIdx.x, wid = tid >> 6, lane = tid & 63;
    __syncthreads();
    if (nc > 0) {
        for (int idx = tid; idx < 16384; idx += 512) { const int k = idx >> 4, c = idx & 15; const int i = k >> 8, ln = (k & 255) >> 2, j = k & 3, c4 = c >> 2, cc = c & 3;
            W[((((i * 4 + j) * 4 + c4) * 64 + ln) * 4) + cc] = c < nc ? wthin[(size_t)k * ldw + c] : 0.f; }
    }
    __syncthreads();
#pragma unroll 1
    for (int rb = blockIdx.x * 8 + wid; rb < MTOK; rb += gridDim.x * 8) {
        const int r = rb;
        f32x4 v[4];
#pragma unroll
        for (int i = 0; i < 4; ++i) v[i] = *(const f32x4*)(src + (size_t)r * DM + i * 256 + lane * 4);
        if (lg) {
            float s = 0.f;
#pragma unroll
            for (int i = 0; i < 4; ++i) s += (v[i][0] + v[i][1]) + (v[i][2] + v[i][3]);
            const float mu = wsum(s) * (1.0f / 1024.0f); float q = 0.f;
#pragma unroll
            for (int i = 0; i < 4; ++i) { const f32x4 d = v[i] - mu; q += (d[0] * d[0] + d[1] * d[1]) + (d[2] * d[2] + d[3] * d[3]); }
            const float rstd = rsqrtf(wsum(q) * (1.0f / 1024.0f) + 1e-5f);
#pragma unroll
            for (int i = 0; i < 4; ++i) { const f32x4 gg = *(const f32x4*)(lg + i * 256 + lane * 4), bb = *(const f32x4*)(lb + i * 256 + lane * 4); v[i] = (v[i] - mu) * rstd * gg + bb; }
        }
#pragma unroll
        for (int i = 0; i < 4; ++i) {
            if (dst) *(f32x4*)(dst + (size_t)r * DM + i * 256 + lane * 4) = v[i];
            if (hb) { u32x2 w; w.x = pk2(v[i][0], v[i][1]); w.y = pk2(v[i][2], v[i][3]); *(u32x2*)(hb + (size_t)r * DM + i * 256 + lane * 4) = w; }
        }
        if (nc > 0) {
            f32x4 a4[4];
#pragma unroll
            for (int c4 = 0; c4 < 4; ++c4) a4[c4] = (f32x4){0.f, 0.f, 0.f, 0.f};
#pragma unroll
            for (int i = 0; i < 4; ++i)
#pragma unroll
                for (int j = 0; j < 4; ++j) {
                    const float yv = v[i][j];
#pragma unroll
                    for (int c4 = 0; c4 < 4; ++c4) a4[c4] += *(const f32x4*)(W + (((i * 4 + j) * 4 + c4) * 64 + lane) * 4) * yv;
                    asm volatile("" ::: "memory");
                }
#pragma unroll
            for (int c4 = 0; c4 < 4; ++c4)
#pragma unroll
                for (int cc = 0; cc < 4; ++cc) { const float t = wsum(a4[c4][cc]); if (lane == c4 * 4 + cc) thin[(size_t)r * 16 + lane] = t; }
        }
    }
    __syncthreads();
}

DEV void convgate(const Params& p, int layer) {
    bf16_t* P = (bf16_t*)(p.ws + OFF_P); const bf16_t* halo = (const bf16_t*)(p.ws + OFF_HALO2);
    const float* cw = p.ffn_conv_w + (size_t)layer * 3 * 5632; const float* cb = p.ffn_conv_b + (size_t)layer * 5632;
    const int tid = threadIdx.x;
    if (tid >= 352) return;
    const int c0 = tid * 8;
    float wg[3][8], wv[3][8], bg[8], bv[8];
#pragma unroll
    for (int j = 0; j < 3; ++j)
#pragma unroll
        for (int e = 0; e < 8; ++e) { wg[j][e] = cw[j * 5632 + c0 + e]; wv[j][e] = cw[j * 5632 + 2816 + c0 + e]; }
#pragma unroll
    for (int e = 0; e < 8; ++e) { bg[e] = cb[c0 + e]; bv[e] = cb[2816 + c0 + e]; }
#pragma unroll 1
    for (int seg = blockIdx.x; seg < 256; seg += gridDim.x) {
        u32x4 g1, g2, v1, v2;
        if ((seg & 63) == 0) { g1 = g2 = v1 = v2 = (u32x4){0u, 0u, 0u, 0u}; }
        else { const bf16_t* hp = halo + (size_t)(seg - 1) * 2 * 5632; g1 = *(const u32x4*)(hp + c0); v1 = *(const u32x4*)(hp + 2816 + c0); g2 = *(const u32x4*)(hp + 5632 + c0); v2 = *(const u32x4*)(hp + 5632 + 2816 + c0); }
        bf16_t* base = P + (size_t)seg * 128 * LDF;
#pragma unroll 1
        for (int t4 = 0; t4 < 128; t4 += 4) {
            u32x4 gr[4], vr[4];
#pragma unroll
            for (int q = 0; q < 4; ++q) { gr[q] = *(const u32x4*)(base + (size_t)(t4 + q) * LDF + c0); vr[q] = *(const u32x4*)(base + (size_t)(t4 + q) * LDF + 2816 + c0); }
#pragma unroll
            for (int q = 0; q < 4; ++q) {
                const u32x4 g3 = gr[q], v3 = vr[q]; u32x4 o;
#pragma unroll
                for (int w = 0; w < 4; ++w) {
                    const float G0 = wg[0][2 * w] * lo2f(g1[w]) + wg[1][2 * w] * lo2f(g2[w]) + wg[2][2 * w] * lo2f(g3[w]) + bg[2 * w];
                    const float G1 = wg[0][2 * w + 1] * hi2f(g1[w]) + wg[1][2 * w + 1] * hi2f(g2[w]) + wg[2][2 * w + 1] * hi2f(g3[w]) + bg[2 * w + 1];
                    const float V0 = wv[0][2 * w] * lo2f(v1[w]) + wv[1][2 * w] * lo2f(v2[w]) + wv[2][2 * w] * lo2f(v3[w]) + bv[2 * w];
                    const float V1 = wv[0][2 * w + 1] * hi2f(v1[w]) + wv[1][2 * w + 1] * hi2f(v2[w]) + wv[2][2 * w + 1] * hi2f(v3[w]) + bv[2 * w + 1];
                    o[w] = pk2(silu(G0) * V0, silu(G1) * V1);
                }
                *(u32x4*)(base + (size_t)(t4 + q) * LDF + c0) = o;
                g1 = g2; g2 = g3; v1 = v2; v2 = v3;
            }
        }
    }
}

DEV void gdn_prep(const Params& p) {
    bf16_t* P = (bf16_t*)(p.ws + OFF_P);
    const float* thin = (const float*)(p.ws + OFF_THIN);
    const bf16_t* halo = (const bf16_t*)(p.ws + OFF_HALO1);
    float* gamG = (float*)(p.ws + OFF_GAM); float* betaG = (float*)(p.ws + OFF_BETA);
    bf16_t* Tg = (bf16_t*)p.out; bf16_t* QKg = Tg + (size_t)3072 * 4096; bf16_t* kTg = QKg + (size_t)3072 * 4096;
    bf16_t* Qs = (bf16_t*)g_shm; bf16_t* Ks = Qs + 64 * 136; float* As = (float*)(g_shm + 2 * 17408); float* gamS = As + 64 * 68; float* betaS = gamS + 64;
    const int tid = threadIdx.x, wid = tid >> 6, lane = tid & 63, fr = lane & 15, fq = lane >> 4;
#pragma unroll 1
    for (int it0 = blockIdx.x; it0 < 3072; it0 += gridDim.x) {
        const int h = it0 % 6, bn = it0 / 6, n = bn & 127, b = bn >> 7;
        const int item = (b * 6 + h) * 128 + n;
        const int t0 = b * SEQ + n * 64;
        u32x4 keep[6];
#pragma unroll
        for (int u6 = 0; u6 < 6; ++u6) {
            const int mat = u6 >> 1, r = (u6 & 1) * 32 + (tid >> 4), cg8 = (tid & 15) * 8;
            const int col = mat * 768 + h * 128 + cg8;
            float y[8];
#pragma unroll
            for (int e = 0; e < 8; ++e) y[e] = 0.f;
#pragma unroll
            for (int j = 0; j < 4; ++j) {
                const int rr = r - 3 + j;
                u32x4 raw = (u32x4){0u, 0u, 0u, 0u};
                if (rr >= 0) raw = *(const u32x4*)(P + (size_t)(t0 + rr) * LDE + col);
                else if (n > 0) raw = *(const u32x4*)(halo + ((size_t)(b * 128 + n - 1) * 3 + (rr + 3)) * 2304 + col);
                const f32x4 w0 = *(const f32x4*)(p.gdn_conv_w + j * 2304 + col), w1 = *(const f32x4*)(p.gdn_conv_w + j * 2304 + col + 4);
                y[0] += w0[0] * lo2f(raw.x); y[1] += w0[1] * hi2f(raw.x); y[2] += w0[2] * lo2f(raw.y); y[3] += w0[3] * hi2f(raw.y);
                y[4] += w1[0] * lo2f(raw.z); y[5] += w1[1] * hi2f(raw.z); y[6] += w1[2] * lo2f(raw.w); y[7] += w1[3] * hi2f(raw.w);
            }
            float ss = 0.f;
#pragma unroll
            for (int e = 0; e < 8; ++e) { y[e] = silu(y[e]); ss += y[e] * y[e]; }
            if (mat < 2) {
                ss += __shfl_xor(ss, 1); ss += __shfl_xor(ss, 2); ss += __shfl_xor(ss, 4); ss += __shfl_xor(ss, 8);
                const float inv = rsqrtf(ss + 1e-6f) * (mat == 0 ? 0.08838834764831845f : 1.0f);
#pragma unroll
                for (int e = 0; e < 8; ++e) y[e] *= inv;
            }
            u32x4 w; w.x = pk2(y[0], y[1]); w.y = pk2(y[2], y[3]); w.z = pk2(y[4], y[5]); w.w = pk2(y[6], y[7]);
            keep[u6] = w;
            if (mat == 0) *(u32x4*)(Qs + r * 136 + cg8) = w;
            if (mat == 1) *(u32x4*)(Ks + r * 136 + cg8) = w;
        }
        if (wid == 0) {
            const int t = t0 + lane;
            const float ba = thin[(size_t)t * 16 + h], aa = thin[(size_t)t * 16 + 6 + h];
            const float beta = 1.0f / (1.0f + expf(-ba));
            const float xx = aa + p.gdn_dt_bias[h];
            const float sp = xx > 20.f ? xx : log1pf(expf(xx));
            float g = -expf(p.gdn_a_log[h]) * sp;
#pragma unroll
            for (int o = 1; o < 64; o <<= 1) { const float tt = __shfl_up(g, o); if (lane >= o) g += tt; }
            gamS[lane] = g; betaS[lane] = beta;
            gamG[(size_t)(b * 6 + h) * SEQ + n * 64 + lane] = g; betaG[(size_t)(b * 6 + h) * SEQ + n * 64 + lane] = beta;
        }
        __syncthreads();
        {
            const int mtx = wid >> 2, itile = wid & 3; const bf16_t* X = mtx ? Qs : Ks;
#pragma unroll
            for (int jt = 0; jt < 4; ++jt) {
                f32x4 acc = (f32x4){0.f, 0.f, 0.f, 0.f};
                if (jt <= itile) {
#pragma unroll
                    for (int kb = 0; kb < 4; ++kb) acc = mfma16(ld8(X + (16 * itile + fr) * 136 + kb * 32 + fq * 8), ld8(Ks + (16 * jt + fr) * 136 + kb * 32 + fq * 8), acc);
                }
#pragma unroll
                for (int jj = 0; jj < 4; ++jj) {
                    const int i = 16 * itile + 4 * fq + jj, j = 16 * jt + fr;
                    const float dec = (i >= j) ? __expf(gamS[i] - gamS[j]) : 0.f;
                    if (mtx == 0) As[i * 68 + j] = (i > j) ? betaS[i] * acc[jj] * dec : 0.f;
                    else QKg[(size_t)item * 4096 + i * 64 + j] = f2bf(acc[jj] * dec);
                }
            }
        }
        __syncthreads();
        if (wid == 0) {
            float t[64];
#pragma unroll
            for (int i = 0; i < 64; ++i) t[i] = 0.f;
#pragma unroll
            for (int i = 0; i < 64; ++i) {
                float s = (i == lane) ? 1.f : 0.f;
#pragma unroll
                for (int j4 = 0; j4 < (i + 3) / 4; ++j4) { const f32x4 a = *(const f32x4*)(As + i * 68 + j4 * 4);
                    s -= a[0] * t[4 * j4]; s -= a[1] * t[4 * j4 + 1]; s -= a[2] * t[4 * j4 + 2]; s -= a[3] * t[4 * j4 + 3]; }
                t[i] = s;
            }
#pragma unroll
            for (int i = 0; i < 64; ++i) Tg[(size_t)item * 4096 + i * 64 + lane] = f2bf(t[i]);
        }
#pragma unroll
        for (int u6 = 0; u6 < 6; ++u6) {
            const int mat = u6 >> 1, r = (u6 & 1) * 32 + (tid >> 4), cg8 = (tid & 15) * 8;
            *(u32x4*)(P + (size_t)(t0 + r) * LDE + mat * 768 + h * 128 + cg8) = keep[u6];
        }
        {
            const int dk = tid >> 2, c0 = (tid & 3) * 16; unsigned w[8];
#pragma unroll
            for (int e = 0; e < 8; ++e) w[e] = (unsigned)Ks[(c0 + 2 * e) * 136 + dk] | ((unsigned)Ks[(c0 + 2 * e + 1) * 136 + dk] << 16);
            u32x4 a = {w[0], w[1], w[2], w[3]}, bq = {w[4], w[5], w[6], w[7]};
            *(u32x4*)(kTg + (size_t)item * 8192 + dk * 64 + c0) = a; *(u32x4*)(kTg + (size_t)item * 8192 + dk * 64 + c0 + 8) = bq;
        }
        __syncthreads();
    }
}

DEV void gdn_scan(const Params& p, int task) {
    const bf16_t* P = (const bf16_t*)(p.ws + OFF_P);
    const float* gamG = (const float*)(p.ws + OFF_GAM); const float* betaG = (const float*)(p.ws + OFF_BETA);
    const bf16_t* Tg = (const bf16_t*)p.out; const bf16_t* QKg = Tg + (size_t)3072 * 4096; const bf16_t* kTg = QKg + (size_t)3072 * 4096;
    bf16_t* mo = (bf16_t*)(p.ws + OFF_HB);
    bf16_t* Kc = (bf16_t*)g_shm; bf16_t* Qc = Kc + 64 * 136; bf16_t* KT = Qc + 64 * 136; bf16_t* Tm = KT + 128 * 72; bf16_t* QK = Tm + 64 * 72; float* gamS = (float*)(QK + 64 * 72); float* betaS = gamS + 64;
    const int tid = threadIdx.x, wid = tid >> 6, lane = tid & 63, fr = lane & 15, fq = lane >> 4;
    const int bh = task >> 2, quarter = task & 3, b = bh / 6, h = bh % 6;
    const size_t tok0 = (size_t)b * SEQ;
    const int dv = quarter * 32 + (wid & 1) * 16 + fr;
    u32x4 rK[2], rQ[2], rKT[2], rT, rQK; float rg = 0.f, rb = 0.f;
    unsigned short vcur[16], vnxt[16];
    f32x4 S[8];
#pragma unroll
    for (int t = 0; t < 8; ++t) S[t] = (f32x4){0.f, 0.f, 0.f, 0.f};
#define GDN_LOAD(n_) do { const int n__ = (n_); const size_t item__ = (size_t)bh * 128 + n__; \
        _Pragma("unroll") for (int i = 0; i < 2; ++i) { const int idx = tid + 512 * i, r = idx >> 4, c8 = (idx & 15) * 8; \
            rK[i] = *(const u32x4*)(P + (tok0 + n__ * 64 + r) * LDE + 768 + h * 128 + c8); rQ[i] = *(const u32x4*)(P + (tok0 + n__ * 64 + r) * LDE + h * 128 + c8); \
            rKT[i] = *(const u32x4*)(kTg + item__ * 8192 + (size_t)idx * 8); } \
        rT = *(const u32x4*)(Tg + item__ * 4096 + (size_t)tid * 8); rQK = *(const u32x4*)(QKg + item__ * 4096 + (size_t)tid * 8); \
        if (tid < 64) { rg = gamG[(size_t)bh * SEQ + n__ * 64 + tid]; rb = betaG[(size_t)bh * SEQ + n__ * 64 + tid]; } } while (0)
#define GDN_STORE() do { \
        _Pragma("unroll") for (int i = 0; i < 2; ++i) { const int idx = tid + 512 * i, r = idx >> 4, c8 = (idx & 15) * 8; \
            *(u32x4*)(Kc + r * 136 + c8) = rK[i]; *(u32x4*)(Qc + r * 136 + c8) = rQ[i]; *(u32x4*)(KT + (idx >> 3) * 72 + (idx & 7) * 8) = rKT[i]; } \
        *(u32x4*)(Tm + (tid >> 3) * 72 + (tid & 7) * 8) = rT; *(u32x4*)(QK + (tid >> 3) * 72 + (tid & 7) * 8) = rQK; \
        if (tid < 64) { gamS[tid] = rg; betaS[tid] = rb; } } while (0)
#define GDN_LOADV(dst, n_) do { if (wid < 2) { _Pragma("unroll") for (int rt = 0; rt < 4; ++rt) _Pragma("unroll") for (int jj = 0; jj < 4; ++jj) \
            dst[rt * 4 + jj] = P[(tok0 + (n_) * 64 + 16 * rt + 4 * fq + jj) * LDE + 1536 + h * 128 + dv]; } } while (0)
    __syncthreads();
    GDN_LOAD(0); GDN_LOADV(vcur, 0); GDN_STORE();
    __syncthreads();
#pragma unroll 1
    for (int n = 0; n < 128; ++n) {
        if (n + 1 < 128) { GDN_LOAD(n + 1); GDN_LOADV(vnxt, n + 1); }
        if (wid < 2) {
            bf16x8 bS[4];
#pragma unroll
            for (int kb = 0; kb < 4; ++kb) bS[kb] = pk8(S[2 * kb], S[2 * kb + 1]);
            f32x4 KS[4], QS[4];
#pragma unroll
            for (int rt = 0; rt < 4; ++rt) {
                f32x4 a = (f32x4){0.f, 0.f, 0.f, 0.f}, c = (f32x4){0.f, 0.f, 0.f, 0.f};
#pragma unroll
                for (int kb = 0; kb < 4; ++kb) { a = mfma16(ldperm(Kc + (16 * rt + fr) * 136 + 32 * kb + 4 * fq), bS[kb], a); c = mfma16(ldperm(Qc + (16 * rt + fr) * 136 + 32 * kb + 4 * fq), bS[kb], c); }
                KS[rt] = a; QS[rt] = c;
            }
            const float gl = gamS[63];
            f32x4 R[4]; float eg[4][4], gm[4][4];
#pragma unroll
            for (int rt = 0; rt < 4; ++rt)
#pragma unroll
                for (int jj = 0; jj < 4; ++jj) {
                    const int i = 16 * rt + 4 * fq + jj; const float g = gamS[i]; gm[rt][jj] = g; eg[rt][jj] = __expf(g);
                    R[rt][jj] = betaS[i] * (bf2f(vcur[rt * 4 + jj]) - eg[rt][jj] * KS[rt][jj]);
                }
            bf16x8 bR[2] = {pk8(R[0], R[1]), pk8(R[2], R[3])};
            f32x4 D[4];
#pragma unroll
            for (int rt = 0; rt < 4; ++rt) {
                f32x4 a = (f32x4){0.f, 0.f, 0.f, 0.f};
#pragma unroll
                for (int kb = 0; kb < 2; ++kb) a = mfma16(ldperm(Tm + (16 * rt + fr) * 72 + 32 * kb + 4 * fq), bR[kb], a);
                D[rt] = a;
            }
            bf16x8 bD[2] = {pk8(D[0], D[1]), pk8(D[2], D[3])};
#pragma unroll
            for (int rt = 0; rt < 4; ++rt) {
                f32x4 a = (f32x4){0.f, 0.f, 0.f, 0.f};
#pragma unroll
                for (int kb = 0; kb < 2; ++kb) a = mfma16(ldperm(QK + (16 * rt + fr) * 72 + 32 * kb + 4 * fq), bD[kb], a);
#pragma unroll
                for (int jj = 0; jj < 4; ++jj) {
                    const float o = eg[rt][jj] * QS[rt][jj] + a[jj];
                    mo[(tok0 + n * 64 + 16 * rt + 4 * fq + jj) * DM + h * 128 + dv] = f2bf(o);
                    D[rt][jj] *= __expf(gl - gm[rt][jj]);
                }
            }
            bf16x8 bE[2] = {pk8(D[0], D[1]), pk8(D[2], D[3])};
            const float egl = __expf(gl);
#pragma unroll
            for (int t = 0; t < 8; ++t) {
                f32x4 a = S[t] * egl;
#pragma unroll
                for (int kb = 0; kb < 2; ++kb) a = mfma16(ldperm(KT + (16 * t + fr) * 72 + 32 * kb + 4 * fq), bE[kb], a);
                S[t] = a;
            }
#pragma unroll
            for (int e = 0; e < 16; ++e) vcur[e] = vnxt[e];
        }
        __syncthreads();
        if (n + 1 < 128) GDN_STORE();
        __syncthreads();
    }
#undef GDN_LOAD
#undef GDN_STORE
#undef GDN_LOADV
}

DEV void swa_item(const Params& p, int item) {
    bf16_t* P = (bf16_t*)(p.ws + OFF_P); float* lseG = (float*)(p.ws + OFF_LSE); const float* blut = (const float*)(p.ws + OFF_BLUT);
    bf16_t* Qs = (bf16_t*)g_shm; bf16_t* Ks = Qs + 128 * 72; bf16_t* Vt = Ks + 256 * 72;
    const int tid = threadIdx.x, wid = tid >> 6, lane = tid & 63, fr = lane & 15, fq = lane >> 4;
    const int blk64 = item & 63, h = (item >> 6) & 3, g = (item >> 8) % 3, b = item / 768;
    const int d = (g == 0) ? 1 : (g == 1 ? 4 : 16), nb = 64 / d;
    const int res = blk64 / nb, ib = blk64 % nb;
    const size_t tok0 = (size_t)b * SEQ;
    const int qcol = 3072 + g * 256 + h * 64, kcol = 3840 + g * 256 + h * 64, vcol = 4608 + g * 256 + h * 64;
    __syncthreads();
#pragma unroll
    for (int i = 0; i < 2; ++i) { const int idx = tid + 512 * i, a = idx >> 3, c8 = (idx & 7) * 8;
        *(u32x4*)(Qs + a * 72 + c8) = *(const u32x4*)(P + (tok0 + (size_t)(128 * ib + a) * d + res) * LDE + qcol + c8); }
#pragma unroll
    for (int i = 0; i < 4; ++i) { const int idx = tid + 512 * i, kj = idx >> 3, c8 = (idx & 7) * 8; const int sk = 128 * (ib - 1) + kj;
        u32x4 kv = (u32x4){0u, 0u, 0u, 0u}, vv = (u32x4){0u, 0u, 0u, 0u};
        if (sk >= 0) { const size_t tok = tok0 + (size_t)sk * d + res; kv = *(const u32x4*)(P + tok * LDE + kcol + c8); vv = *(const u32x4*)(P + tok * LDE + vcol + c8); }
        *(u32x4*)(Ks + kj * 72 + c8) = kv;
#pragma unroll
        for (int e = 0; e < 4; ++e) { Vt[(c8 + 2 * e) * 264 + kj] = (bf16_t)(vv[e] & 0xffffu); Vt[(c8 + 2 * e + 1) * 264 + kj] = (bf16_t)(vv[e] >> 16); } }
    __syncthreads();
    {
        const int a0 = 16 * wid;
        const bf16x8 bq0 = ld8(Qs + (a0 + fr) * 72 + fq * 8), bq1 = ld8(Qs + (a0 + fr) * 72 + 32 + fq * 8);
        f32x4 s[10];
        float mx = -INFINITY;
        const float* bl = blut + h * NLUT;
#pragma unroll
        for (int kt = 0; kt < 9; ++kt) {
            f32x4 acc = (f32x4){0.f, 0.f, 0.f, 0.f};
            acc = mfma16(ld8(Ks + (a0 + 16 * kt + fr) * 72 + fq * 8), bq0, acc);
            acc = mfma16(ld8(Ks + (a0 + 16 * kt + fr) * 72 + 32 + fq * 8), bq1, acc);
#pragma unroll
            for (int jj = 0; jj < 4; ++jj) {
                const int rel = fr + 128 - 16 * kt - 4 * fq - jj; const int kj = a0 + 16 * kt + 4 * fq + jj;
                const bool ok = (rel >= 0) && (rel <= 128) && (ib > 0 || kj >= 128);
                const int di = min(max(rel, 0) * d, NLUT - 1);
                const float sc = ok ? (acc[jj] * 0.125f + bl[di]) : -INFINITY;
                s[kt][jj] = sc; mx = fmaxf(mx, sc);
            }
        }
        s[9] = (f32x4){-INFINITY, -INFINITY, -INFINITY, -INFINITY};
        mx = fmaxf(mx, __shfl_xor(mx, 16)); mx = fmaxf(mx, __shfl_xor(mx, 32));
        float l = 0.f;
#pragma unroll
        for (int kt = 0; kt < 10; ++kt)
#pragma unroll
            for (int jj = 0; jj < 4; ++jj) { const float pe = __expf(s[kt][jj] - mx); s[kt][jj] = pe; l += pe; }
        l += __shfl_xor(l, 16); l += __shfl_xor(l, 32);
        f32x4 O[4];
#pragma unroll
        for (int dt = 0; dt < 4; ++dt) O[dt] = (f32x4){0.f, 0.f, 0.f, 0.f};
#pragma unroll
        for (int ks = 0; ks < 5; ++ks) {
            const bf16x8 bp = pk8(s[2 * ks], s[2 * ks + 1]);
#pragma unroll
            for (int dt = 0; dt < 4; ++dt) {
                const bf16_t* vp = Vt + (16 * dt + fr) * 264 + a0 + 32 * ks + 4 * fq;
                const u32x2 lo = *(const u32x2*)vp; u32x2 hi = (u32x2){0u, 0u};
                if (ks < 4) hi = *(const u32x2*)(vp + 16);
                O[dt] = mfma16(mk8(lo.x, lo.y, hi.x, hi.y), bp, O[dt]);
            }
        }
        const float inv = 1.0f / l;
        const size_t tok = tok0 + (size_t)(128 * ib + a0 + fr) * d + res;
#pragma unroll
        for (int dt = 0; dt < 4; ++dt) { u32x2 w; w.x = pk2(O[dt][0] * inv, O[dt][1] * inv); w.y = pk2(O[dt][2] * inv, O[dt][3] * inv);
            *(u32x2*)(P + tok * LDE + qcol + 16 * dt + 4 * fq) = w; }
        if (fq == 0) lseG[tok * 12 + g * 4 + h] = mx + __logf(l);
    }
}

DEV void even_post(const Params& p) {
    const bf16_t* P = (const bf16_t*)(p.ws + OFF_P); const float* lseG = (const float*)(p.ws + OFF_LSE); bf16_t* mo = (bf16_t*)(p.ws + OFF_HB);
    const int tid = threadIdx.x, wid = tid >> 6, lane = tid & 63;
    const float nw0 = p.gdn_norm_w[2 * lane], nw1 = p.gdn_norm_w[2 * lane + 1];
#pragma unroll 1
    for (int tok = blockIdx.x * 8 + wid; tok < MTOK; tok += gridDim.x * 8) {
#pragma unroll
        for (int h = 0; h < 6; ++h) {
            const unsigned raw = *(const unsigned*)(mo + (size_t)tok * DM + h * 128 + 2 * lane), z = *(const unsigned*)(P + (size_t)tok * LDE + 2304 + h * 128 + 2 * lane);
            const float a = lo2f(raw), c = hi2f(raw);
            const float rstd = rsqrtf(wsum(a * a + c * c) * (1.0f / 128.0f) + 1e-6f);
            *(unsigned*)(mo + (size_t)tok * DM + h * 128 + 2 * lane) = pk2(a * rstd * nw0 * silu(lo2f(z)), c * rstd * nw1 * silu(hi2f(z)));
        }
        const int hh = lane >> 4, d4 = (lane & 15) * 4;
        const float l0 = lseG[(size_t)tok * 12 + hh], l1 = lseG[(size_t)tok * 12 + 4 + hh], l2 = lseG[(size_t)tok * 12 + 8 + hh];
        const float m = fmaxf(l0, fmaxf(l1, l2)); float w0 = __expf(l0 - m), w1 = __expf(l1 - m), w2 = __expf(l2 - m); const float iv = 1.0f / (w0 + w1 + w2); w0 *= iv; w1 *= iv; w2 *= iv;
        const u32x2 o0 = *(const u32x2*)(P + (size_t)tok * LDE + 3072 + hh * 64 + d4), o1 = *(const u32x2*)(P + (size_t)tok * LDE + 3072 + 256 + hh * 64 + d4), o2 = *(const u32x2*)(P + (size_t)tok * LDE + 3072 + 512 + hh * 64 + d4);
        u32x2 w;
        w.x = pk2(w0 * lo2f(o0.x) + w1 * lo2f(o1.x) + w2 * lo2f(o2.x), w0 * hi2f(o0.x) + w1 * hi2f(o1.x) + w2 * hi2f(o2.x));
        w.y = pk2(w0 * lo2f(o0.y) + w1 * lo2f(o1.y) + w2 * lo2f(o2.y), w0 * hi2f(o0.y) + w1 * hi2f(o1.y) + w2 * hi2f(o2.y));
        *(u32x2*)(mo + (size_t)tok * DM + 768 + hh * 64 + d4) = w;
    }
}

DEV void diff_item(const Params& p, int item) {
    const bf16_t* P = (const bf16_t*)(p.ws + OFF_P); bf16_t* mo = (bf16_t*)(p.ws + OFF_HB);
    bf16_t* Ks = (bf16_t*)g_shm;
    bf16_t* Vt = Ks + 2 * 64 * 136;
    float* bl = (float*)(Vt + 2 * 128 * 72);
    const int tid = threadIdx.x, wid = tid >> 6, lane = tid & 63, fr = lane & 15, fq = lane >> 4;
    const int qb = 63 - (item >> 4), bh = item & 15, b = bh >> 2, h = bh & 3;
    const size_t tok0 = (size_t)b * SEQ;
    const int q0 = qb * 128, qw0 = q0 + 16 * wid, qrow = qw0 + fr;
    const int nkt = 2 * (qb + 1);
    const float lam = *(const float*)(p.ws + OFF_LAM);
    __syncthreads();
    { const float* blg = (const float*)(p.ws + OFF_BLUT) + h * NLUT; for (int i = tid; i < NLUT; i += 512) bl[i] = blg[i] * LOG2E; }
    bf16x8 bq[2][2];
#pragma unroll
    for (int c = 0; c < 2; ++c)
#pragma unroll
        for (int kb = 0; kb < 2; ++kb) bq[c][kb] = *(const bf16x8*)(P + (tok0 + qrow) * LDO + h * 128 + c * 64 + kb * 32 + fq * 8);
    u32x4 rk[2], rv[2];
#define DF_LOAD(kt_) do { _Pragma("unroll") for (int i = 0; i < 2; ++i) { const int idx = tid + 512 * i, r = idx >> 4, c8 = (idx & 15) * 8; \
        rk[i] = *(const u32x4*)(P + (tok0 + (size_t)(kt_) * 64 + r) * LDO + 512 + h * 128 + c8); rv[i] = *(const u32x4*)(P + (tok0 + (size_t)(kt_) * 64 + r) * LDO + 1024 + h * 128 + c8); } } while (0)
#define DF_STORE(buf_) do { bf16_t* K_ = Ks + (buf_) * 64 * 136; bf16_t* V_ = Vt + (buf_) * 128 * 72; \
        _Pragma("unroll") for (int i = 0; i < 2; ++i) { const int idx = tid + 512 * i, r = idx >> 4, c8 = (idx & 15) * 8; *(u32x4*)(K_ + r * 136 + c8) = rk[i]; \
            _Pragma("unroll") for (int e = 0; e < 4; ++e) { V_[(c8 + 2 * e) * 72 + r] = (bf16_t)(rv[i][e] & 0xffffu); V_[(c8 + 2 * e + 1) * 72 + r] = (bf16_t)(rv[i][e] >> 16); } } } while (0)
    DF_LOAD(0); DF_STORE(0);
    __syncthreads();
    f32x4 O[2][8]; float m[2] = {-INFINITY, -INFINITY}, l[2] = {0.f, 0.f};
#pragma unroll
    for (int c = 0; c < 2; ++c)
#pragma unroll
        for (int dt = 0; dt < 8; ++dt) O[c][dt] = (f32x4){0.f, 0.f, 0.f, 0.f};
    const float SC = 0.125f * LOG2E;
#pragma unroll 1
    for (int kt = 0; kt < nkt; ++kt) {
        const int buf = kt & 1, k0 = kt * 64;
        if (kt + 1 < nkt) DF_LOAD(kt + 1);
        if (k0 <= qw0 + 15) {
            const bf16_t* K_ = Ks + buf * 64 * 136; const bf16_t* V_ = Vt + buf * 128 * 72;
            const bool need_mask = (k0 + 63 > qw0);
            const bool far = (qw0 - (k0 + 63) >= NLUT - 1);
            const float bfar = bl[NLUT - 1];
            bf16x8 bp[2][2];
#pragma unroll
            for (int c = 0; c < 2; ++c) {
                f32x4 s[4]; float mt = -INFINITY;
#pragma unroll
                for (int k4 = 0; k4 < 4; ++k4) {
                    f32x4 acc = (f32x4){0.f, 0.f, 0.f, 0.f};
                    acc = mfma16(ld8(K_ + (16 * k4 + fr) * 136 + c * 64 + fq * 8), bq[c][0], acc);
                    acc = mfma16(ld8(K_ + (16 * k4 + fr) * 136 + c * 64 + 32 + fq * 8), bq[c][1], acc);
#pragma unroll
                    for (int jj = 0; jj < 4; ++jj) {
                        const int kpos = k0 + 16 * k4 + 4 * fq + jj; const int dist = qrow - kpos;
                        float bias = bfar;
                        if (!far) bias = bl[min(max(dist, 0), NLUT - 1)];
                        float sc = acc[jj] * SC + bias;
                        if (need_mask && dist < 0) sc = -INFINITY;
                        s[k4][jj] = sc; mt = fmaxf(mt, sc);
                    }
                }
                mt = fmaxf(mt, __shfl_xor(mt, 16)); mt = fmaxf(mt, __shfl_xor(mt, 32));
                const float mn = fmaxf(m[c], mt); const float al = ex2(m[c] - mn); m[c] = mn;
                float ls = 0.f;
#pragma unroll
                for (int k4 = 0; k4 < 4; ++k4)
#pragma unroll
                    for (int jj = 0; jj < 4; ++jj) { const float pe = ex2(s[k4][jj] - mn); s[k4][jj] = pe; ls += pe; }
                l[c] = l[c] * al + ls;
#pragma unroll
                for (int dt = 0; dt < 8; ++dt) O[c][dt] *= al;
                bp[c][0] = pk8(s[0], s[1]); bp[c][1] = pk8(s[2], s[3]);
            }
#pragma unroll
            for (int ks = 0; ks < 2; ++ks)
#pragma unroll
                for (int dt = 0; dt < 8; ++dt) {
                    const bf16x8 a = ldperm(V_ + (16 * dt + fr) * 72 + 32 * ks + 4 * fq);
                    O[0][dt] = mfma16(a, bp[0][ks], O[0][dt]); O[1][dt] = mfma16(a, bp[1][ks], O[1][dt]);
                }
        }
        if (kt + 1 < nkt) DF_STORE(buf ^ 1);
        __syncthreads();
    }
#undef DF_LOAD
#undef DF_STORE
    {
        float l0 = l[0], l1 = l[1];
        l0 += __shfl_xor(l0, 16); l0 += __shfl_xor(l0, 32); l1 += __shfl_xor(l1, 16); l1 += __shfl_xor(l1, 32);
        const float i0 = 1.0f / l0, i1 = lam / l1;
        float ss = 0.f;
#pragma unroll
        for (int dt = 0; dt < 8; ++dt) { O[0][dt] = O[0][dt] * i0 - O[1][dt] * i1; ss += (O[0][dt][0] * O[0][dt][0] + O[0][dt][1] * O[0][dt][1]) + (O[0][dt][2] * O[0][dt][2] + O[0][dt][3] * O[0][dt][3]); }
        ss += __shfl_xor(ss, 16); ss += __shfl_xor(ss, 32);
        const float rs = rsqrtf(ss * (1.0f / 128.0f) + 1e-6f) * (1.0f - LAM_INIT);
#pragma unroll
        for (int dt = 0; dt < 8; ++dt) {
            const f32x4 nw = *(const f32x4*)(p.diff_norm_w + 16 * dt + 4 * fq);
            u32x2 w; w.x = pk2(O[0][dt][0] * rs * nw[0], O[0][dt][1] * rs * nw[1]); w.y = pk2(O[0][dt][2] * rs * nw[2], O[0][dt][3] * rs * nw[3]);
            *(u32x2*)(mo + (tok0 + qrow) * DM + h * 128 + 16 * dt + 4 * fq) = w;
        }
    }
}

DEV void gla_task(const Params& p, int task) {
    const bf16_t* P = (const bf16_t*)(p.ws + OFF_P); bf16_t* mo = (bf16_t*)(p.ws + OFF_HB); const float* thin = (const float*)(p.ws + OFF_THIN);
    bf16_t* qt = (bf16_t*)g_shm; bf16_t* kt = qt + 64 * 72; bf16_t* khT = kt + 64 * 72; bf16_t* vT = khT + 64 * 72; bf16_t* at = vT + 128 * 72;
    float* bL = (float*)(at + 64 * 72); float* el = bL + 64 * 65; float* ssq = el + 64;
    const int tid = threadIdx.x, wid = tid >> 6, lane = tid & 63, fr = lane & 15, fq = lane >> 4;
    const int b = task >> 2, h = task & 3; const size_t tok0 = (size_t)b * SEQ;
    const int kch = tid & 63;
    float wg[16];
#pragma unroll
    for (int j = 0; j < 16; ++j) wg[j] = p.gla_w_gate[j * 256 + h * 64 + kch];
    const float bgate = p.gla_b_gate[h * 64 + kch];
    const int dv = 16 * wid + fr;
    const float nw = p.gla_norm_w[dv];
    f32x4 S[4];
#pragma unroll
    for (int t = 0; t < 4; ++t) S[t] = (f32x4){0.f, 0.f, 0.f, 0.f};
    __syncthreads();
#pragma unroll 1
    for (int n = 0; n < 128; ++n) {
        const size_t t0 = tok0 + (size_t)n * 64;
#pragma unroll
        for (int it = 0; it < 8; ++it) {
            const int r = (tid >> 6) + 8 * it; const float* gd = thin + (t0 + r) * 16;
            float x = bgate;
#pragma unroll
            for (int j = 0; j < 16; ++j) x += gd[j] * wg[j];
            const float ls = fminf(x, 0.f) - log1pf(__expf(-fabsf(x)));
            bL[r * 65 + kch] = ls * (1.0f / 16.0f);
        }
        __syncthreads();
        if (tid < 64) { float acc = 0.f; for (int r = 0; r < 64; ++r) { acc += bL[r * 65 + tid]; bL[r * 65 + tid] = acc; } el[tid] = __expf(acc); }
        __syncthreads();
        {
            const int r = tid >> 3, c8 = (tid & 7) * 8;
            const u32x4 qr = *(const u32x4*)(P + (t0 + r) * LDO + 1536 + h * 64 + c8), kr = *(const u32x4*)(P + (t0 + r) * LDO + 1792 + h * 64 + c8);
            float qf[8], kf[8], kh[8];
#pragma unroll
            for (int e = 0; e < 4; ++e) { qf[2 * e] = lo2f(qr[e]); qf[2 * e + 1] = hi2f(qr[e]); kf[2 * e] = lo2f(kr[e]); kf[2 * e + 1] = hi2f(kr[e]); }
#pragma unroll
            for (int e = 0; e < 8; ++e) { const float bb = bL[r * 65 + c8 + e], blast = bL[63 * 65 + c8 + e];
                qf[e] *= 0.125f * __expf(bb); kh[e] = kf[e] * __expf(blast - bb); kf[e] *= __expf(fminf(-bb, 80.f)); }
            u32x4 w; w.x = pk2(qf[0], qf[1]); w.y = pk2(qf[2], qf[3]); w.z = pk2(qf[4], qf[5]); w.w = pk2(qf[6], qf[7]); *(u32x4*)(qt + r * 72 + c8) = w;
            w.x = pk2(kf[0], kf[1]); w.y = pk2(kf[2], kf[3]); w.z = pk2(kf[4], kf[5]); w.w = pk2(kf[6], kf[7]); *(u32x4*)(kt + r * 72 + c8) = w;
#pragma unroll
            for (int e = 0; e < 8; ++e) khT[(c8 + e) * 72 + r] = f2bf(kh[e]);
#pragma unroll
            for (int i = 0; i < 2; ++i) { const int idx = tid + 512 * i, rr = idx >> 4, v8 = (idx & 15) * 8; const u32x4 vr = *(const u32x4*)(P + (t0 + rr) * LDO + 2048 + h * 128 + v8);
#pragma unroll
                for (int e = 0; e < 4; ++e) { vT[(v8 + 2 * e) * 72 + rr] = (bf16_t)(vr[e] & 0xffffu); vT[(v8 + 2 * e + 1) * 72 + rr] = (bf16_t)(vr[e] >> 16); } }
        }
        __syncthreads();
#pragma unroll
        for (int tt = 0; tt < 2; ++tt) {
            const int tile = 2 * wid + tt, itile = tile >> 2, jt = tile & 3;
            f32x4 acc = (f32x4){0.f, 0.f, 0.f, 0.f};
            if (jt <= itile) {
#pragma unroll
                for (int kb = 0; kb < 2; ++kb) acc = mfma16(ld8(qt + (16 * itile + fr) * 72 + kb * 32 + fq * 8), ld8(kt + (16 * jt + fr) * 72 + kb * 32 + fq * 8), acc);
            }
#pragma unroll
            for (int jj = 0; jj < 4; ++jj) { const int i = 16 * itile + 4 * fq + jj, j = 16 * jt + fr; at[i * 72 + j] = (i >= j) ? f2bf(acc[jj]) : (bf16_t)0; }
        }
        __syncthreads();
        f32x4 o[4];
        {
            const bf16x8 bS0 = pk8(S[0], S[1]), bS1 = pk8(S[2], S[3]);
            const bf16x8 bv0 = ld8(vT + dv * 72 + fq * 8), bv1 = ld8(vT + dv * 72 + 32 + fq * 8);
#pragma unroll
            for (int rt = 0; rt < 4; ++rt) {
                f32x4 a = (f32x4){0.f, 0.f, 0.f, 0.f};
                a = mfma16(ldperm(qt + (16 * rt + fr) * 72 + 4 * fq), bS0, a);
                a = mfma16(ldperm(qt + (16 * rt + fr) * 72 + 32 + 4 * fq), bS1, a);
                a = mfma16(ld8(at + (16 * rt + fr) * 72 + fq * 8), bv0, a);
                a = mfma16(ld8(at + (16 * rt + fr) * 72 + 32 + fq * 8), bv1, a);
                o[rt] = a;
            }
#pragma unroll
            for (int t = 0; t < 4; ++t) {
                f32x4 a;
#pragma unroll
                for (int jj = 0; jj < 4; ++jj) a[jj] = S[t][jj] * el[16 * t + 4 * fq + jj];
                a = mfma16(ld8(khT + (16 * t + fr) * 72 + fq * 8), bv0, a);
                a = mfma16(ld8(khT + (16 * t + fr) * 72 + 32 + fq * 8), bv1, a);
                S[t] = a;
            }
#pragma unroll
            for (int rt = 0; rt < 4; ++rt)
#pragma unroll
                for (int jj = 0; jj < 4; ++jj) {
                    float q2 = o[rt][jj] * o[rt][jj];
                    q2 += __shfl_xor(q2, 1); q2 += __shfl_xor(q2, 2); q2 += __shfl_xor(q2, 4); q2 += __shfl_xor(q2, 8);
                    if (fr == 0) ssq[(16 * rt + 4 * fq + jj) * 8 + wid] = q2;
                }
        }
        __syncthreads();
#pragma unroll
        for (int rt = 0; rt < 4; ++rt)
#pragma unroll
            for (int jj = 0; jj < 4; ++jj) {
                const int i = 16 * rt + 4 * fq + jj;
                const f32x4 s0 = *(const f32x4*)(ssq + i * 8), s1 = *(const f32x4*)(ssq + i * 8 + 4);
                const float tot = (s0[0] + s0[1]) + (s0[2] + s0[3]) + (s1[0] + s1[1]) + (s1[2] + s1[3]);
                const float rs = rsqrtf(tot * (1.0f / 128.0f) + 1e-6f);
                const float rg = bf2f(P[(t0 + i) * LDO + 2560 + h * 128 + dv]);
                mo[(t0 + i) * DM + 512 + h * 128 + dv] = f2bf(o[rt][jj] * rs * nw * silu(rg));
            }
        __syncthreads();
    }
}

#ifndef PH_LO
#define PH_LO 0
#define PH_HI 99
#endif
#define PHASE(k) if ((k) >= PH_LO && (k) <= PH_HI)
#ifdef MULTI_LAUNCH
#define GSYNC()
#else
#define GSYNC() grid.sync()
#endif

template <int LO, int HI> __global__ void __launch_bounds__(512, 2) mega(Params p) {
#ifndef MULTI_LAUNCH
    cg::grid_group grid = cg::this_grid();
#endif
    bf16_t* P = (bf16_t*)(p.ws + OFF_P); bf16_t* HB = (bf16_t*)(p.ws + OFF_HB); bf16_t* WT = (bf16_t*)(p.ws + OFF_WT);
    float* thin = (float*)(p.ws + OFF_THIN);
#define STEP(k) if ((k) >= LO && (k) <= HI)
    STEP(0) { phase_weights(p); rowpass(p.x, nullptr, HB, nullptr, nullptr, p.w_in_even + 3072, 5388, 12, thin); }
    if (0 >= LO && 0 < HI) GSYNC();
    STEP(1) { EpiStoreBf16 E; E.O = P; E.ldc = LDE; E.halo = (bf16_t*)(p.ws + OFF_HALO1); E.seg = 64; E.hrows = 3; E.hcols = 2304; run_gemm(HB, DM, WT + W_INE, MTOK, LDE, DM, E); }
    if (1 >= LO && 1 < HI) GSYNC();
    STEP(2) { gdn_prep(p); }
    if (2 >= LO && 2 < HI) GSYNC();
    STEP(3) {
        for (int task = blockIdx.x; task < 96; task += gridDim.x) gdn_scan(p, task);
        const int nsw = (int)gridDim.x > 96 ? (int)gridDim.x - 96 : (int)gridDim.x; const int first = (int)gridDim.x > 96 ? (int)blockIdx.x - 96 : (int)blockIdx.x;
        if (first >= 0) for (int item = first; item < 3072; item += nsw) swa_item(p, item);
    }
    if (3 >= LO && 3 < HI) GSYNC();
    STEP(4) { even_post(p); }
    if (4 >= LO && 4 < HI) GSYNC();
    STEP(5) { EpiResF32 E; E.base = p.x; E.out = p.out; E.ldc = DM; E.alpha = DN_ALPHA; run_gemm(HB, DM, WT + W_OUTE, MTOK, DM, DM, E); }
    if (5 >= LO && 5 < HI) GSYNC();
    STEP(6) { rowpass(p.out, p.out, HB, p.ln_g, p.ln_b, nullptr, 0, 0, nullptr); }
    if (6 >= LO && 6 < HI) GSYNC();
    STEP(7) { EpiStoreBf16 E; E.O = P; E.ldc = LDF; E.halo = (bf16_t*)(p.ws + OFF_HALO2); E.seg = 128; E.hrows = 2; E.hcols = 5632; run_gemm(HB, DM, WT + W_UP0, MTOK, LDF, DM, E); }
    if (7 >= LO && 7 < HI) GSYNC();
    STEP(8) { convgate(p, 0); }
    if (8 >= LO && 8 < HI) GSYNC();
    STEP(9) { EpiResF32 E; E.base = p.out; E.out = p.out; E.ldc = DM; E.alpha = DN_ALPHA; run_gemm(P, LDF, WT + W_DN0, MTOK, DM, 2816, E); }
    if (9 >= LO && 9 < HI) GSYNC();
    STEP(10) { rowpass(p.out, p.out, HB, p.ln_g + 1024, p.ln_b + 1024, p.w_in_odd + 3072, 3088, 16, thin); }
    if (10 >= LO && 10 < HI) GSYNC();
    STEP(11) { EpiStoreBf16 E; E.O = P; E.ldc = LDO; E.halo = nullptr; E.seg = 64; E.hrows = 0; E.hcols = 0; run_gemm(HB, DM, WT + W_INO, MTOK, LDO, DM, E); }
    if (11 >= LO && 11 < HI) GSYNC();
    STEP(12) {
        for (int task = blockIdx.x; task < 16; task += gridDim.x) gla_task(p, task);
        unsigned* cnt = (unsigned*)(p.ws + OFF_CNT); int* s_item_p = (int*)(g_shm + 131056);
        for (;;) {
            __syncthreads();
            if (threadIdx.x == 0) *s_item_p = (int)atomicAdd(cnt, 1u);
            __syncthreads();
            const int item = *s_item_p;
            if (item >= 1024) break;
            diff_item(p, item);
        }
    }
    if (12 >= LO && 12 < HI) GSYNC();
    STEP(13) { EpiResF32 E; E.base = p.out; E.out = p.out; E.ldc = DM; E.alpha = DN_ALPHA; run_gemm(HB, DM, WT + W_OUTO, MTOK, DM, DM, E); }
    if (13 >= LO && 13 < HI) GSYNC();
    STEP(14) { rowpass(p.out, p.out, HB, p.ln_g + 2048, p.ln_b + 2048, nullptr, 0, 0, nullptr); }
    if (14 >= LO && 14 < HI) GSYNC();
    STEP(15) { EpiStoreBf16 E; E.O = P; E.ldc = LDF; E.halo = (bf16_t*)(p.ws + OFF_HALO2); E.seg = 128; E.hrows = 2; E.hcols = 5632; run_gemm(HB, DM, WT + W_UP1, MTOK, LDF, DM, E); }
    if (15 >= LO && 15 < HI) GSYNC();
    STEP(16) { convgate(p, 1); }
    if (16 >= LO && 16 < HI) GSYNC();
    STEP(17) { EpiResF32 E; E.base = p.out; E.out = p.out; E.ldc = DM; E.alpha = DN_ALPHA; run_gemm(P, LDF, WT + W_DN1, MTOK, DM, 2816, E); }
    if (17 >= LO && 17 < HI) GSYNC();
    STEP(18) { rowpass(p.out, p.out, nullptr, p.ln_g + 3072, p.ln_b + 3072, nullptr, 0, 0, nullptr); }
#undef STEP
}

#ifdef DUMP_ODD
__global__ void dump_odd(Params p) {
    const bf16_t* P = (const bf16_t*)(p.ws + OFF_P); const float* thin = (const float*)(p.ws + OFF_THIN);
    for (size_t i = (size_t)blockIdx.x * 512 + threadIdx.x; i < (size_t)MTOK * 1024; i += (size_t)gridDim.x * 512) {
        const size_t row = i >> 10; const int c = (int)(i & 1023);
        p.out[i] = c < 16 ? thin[row * 16 + c] : bf2f(P[row * LDO + 1536 + c]);
    }
}
#endif
constexpr size_t kDynLds = 131072;

extern "C" void kernel_launch(void* const* d_in, const int* in_sizes, int n_in, void* d_out, int out_size, void* d_ws, size_t ws_size, hipStream_t stream) {
    (void)in_sizes; (void)n_in; (void)out_size;
    if (ws_size < WS_NEED) { fprintf(stderr, "workspace too small: %zu < %zu\n", ws_size, (size_t)WS_NEED); return; }
    Params p{};
    const float** f = (const float**)&p;
    for (int i = 0; i < 21; ++i) f[i] = (const float*)d_in[i];
    p.out = (float*)d_out; p.ws = (unsigned char*)d_ws;
#ifdef MULTI_LAUNCH
    static bool attr = false;
#define LAUNCH1(k) do { hipFuncSetAttribute((const void*)mega<k, k>, hipFuncAttributeMaxDynamicSharedMemorySize, (int)kDynLds); \
        hipLaunchKernelGGL((mega<k, k>), dim3(256), dim3(512), kDynLds, stream, p); } while (0)
#ifndef LASTPH
#define LASTPH 18
#endif
#define LAUNCHIF(k) do { if ((k) <= LASTPH) LAUNCH1(k); } while (0)
    LAUNCHIF(0); LAUNCHIF(1); LAUNCHIF(2); LAUNCHIF(3); LAUNCHIF(4); LAUNCHIF(5); LAUNCHIF(6); LAUNCHIF(7); LAUNCHIF(8); LAUNCHIF(9);
    LAUNCHIF(10); LAUNCHIF(11); LAUNCHIF(12); LAUNCHIF(13); LAUNCHIF(14); LAUNCHIF(15); LAUNCHIF(16); LAUNCHIF(17); LAUNCHIF(18);
    (void)attr;
#ifdef DUMP_ODD
    hipLaunchKernelGGL(dump_odd, dim3(1024), dim3(512), 0, stream, p);
#endif
#else
    static int grid_blocks = 0;
    if (!grid_blocks) {
        int dev = 0, cus = 0, per_cu = 0;
        hipGetDevice(&dev);
        hipDeviceGetAttribute(&cus, hipDeviceAttributeMultiprocessorCount, dev);
        hipFuncSetAttribute((const void*)mega<0, 99>, hipFuncAttributeMaxDynamicSharedMemorySize, (int)kDynLds);
        hipOccupancyMaxActiveBlocksPerMultiprocessor(&per_cu, mega<0, 99>, 512, kDynLds);
        if (per_cu < 1) per_cu = 1;
        grid_blocks = cus * per_cu;
        if (grid_blocks > 256) grid_blocks = 256;
    }
    void* args[] = {&p};
    hipError_t e = hipLaunchCooperativeKernel((void*)mega<0, 99>, dim3(grid_blocks), dim3(512), args, kDynLds, stream);
    if (e != hipSuccess) fprintf(stderr, "cooperative launch failed: %s (grid %d)\n", hipGetErrorString(e), grid_blocks);
#endif
}
```

```cpp
#include <hip/hip_runtime.h>
#include <hip/hip_cooperative_groups.h>
#include <cstdio>
#include <cstdint>
namespace cg = cooperative_groups;

extern __shared__ __attribute__((aligned(16))) unsigned char g_shm[];
#define XB_TMO      128
#define XB_XCNT(j)  (256  + 64 * (j))
#define XB_XSUB(j)  (1280 + 64 * (j))
#define XB_XGEN(j)  (2304 + 64 * (j))
#define XB_TOP      3328
#define XB_TOPGEN   3392
#define XCD_BAR_WORDS 3456
#define XB_SPIN_CAP (1u << 18)
#define XB_LAS __attribute__((address_space(3)))

__device__ __forceinline__ unsigned xb_ld(unsigned* p)              { return __hip_atomic_load(p, __ATOMIC_RELAXED, __HIP_MEMORY_SCOPE_AGENT); }
__device__ __forceinline__ unsigned xb_add(unsigned* p, unsigned v) { return __hip_atomic_fetch_add(p, v, __ATOMIC_RELAXED, __HIP_MEMORY_SCOPE_AGENT); }
__device__ __forceinline__ unsigned xb_xcc_id() { return (unsigned)__builtin_amdgcn_s_getreg((3 << 11) | 20) & 0xFu; }
#define XB_SPIN(cond, bar) do { unsigned _sp = 0; while (cond) { __builtin_amdgcn_s_sleep(1); \
    if ((++_sp & 255u) == 0u) { if (xb_ld(&(bar)[XB_TMO])) break; if (_sp > XB_SPIN_CAP) { atomicAdd(&(bar)[XB_TMO], 1u); break; } } } } while (0)

struct XcdBarrier {
    unsigned* bar; unsigned x;
    volatile XB_LAS unsigned* st;
};

__device__ __forceinline__ XcdBarrier xcd_barrier_post(unsigned* bar, volatile XB_LAS unsigned* st) {
    XcdBarrier b; b.bar = bar; b.x = xb_xcc_id(); b.st = st;
    if (threadIdx.x == 0) (void)xb_add(&bar[XB_XCNT(b.x)], 1u);
    return b;
}
__device__ __forceinline__ void xcd_barrier_complete(unsigned* bar, unsigned x, unsigned& nloc, unsigned& nx) {
    const unsigned G = gridDim.x * gridDim.y * gridDim.z;
    unsigned sum, cnt, mine, sp = 0u;
    for (;;) {
        sum = 0u; cnt = 0u; mine = 0u;
#pragma unroll
        for (unsigned j = 0; j < 16; ++j) { const unsigned c = xb_ld(&bar[XB_XCNT(j)]); sum += c; cnt += (c > 0u) ? 1u : 0u; mine = (j == x) ? c : mine; }
        if (sum == G) break;
        __builtin_amdgcn_s_sleep(1);
        if ((++sp & 255u) == 0u) { if (xb_ld(&bar[XB_TMO])) break; if (sp > XB_SPIN_CAP) { atomicAdd(&bar[XB_TMO], 1u); break; } }
    }
    nloc = mine > 0u ? mine : 1u; nx = cnt > 0u ? cnt : 1u;
}

__device__ __forceinline__ void xcd_barrier(const XcdBarrier& b) {
    asm volatile("s_waitcnt vmcnt(0)" ::: "memory");
    __syncthreads();
    if (threadIdx.x == 0) {
        unsigned* bar = b.bar;
        __builtin_amdgcn_s_waitcnt(0);
        unsigned nloc = b.st[0], nx = b.st[1];
        if (nloc == 0u) { xcd_barrier_complete(bar, b.x, nloc, nx); b.st[0] = nloc; b.st[1] = nx; }
        const unsigned old = xb_add(&bar[XB_XSUB(b.x)], 1u);
        const unsigned gen = old / nloc;
        if (old + 1u == (gen + 1u) * nloc) {
            __builtin_amdgcn_fence(__ATOMIC_RELEASE, "agent");
            asm volatile("s_waitcnt vmcnt(0)" ::: "memory");
            const unsigned og = xb_add(&bar[XB_TOP], 1u);
            const unsigned tg = og / nx;
            if (og + 1u == (tg + 1u) * nx) xb_add(&bar[XB_TOPGEN], 1u);
            else XB_SPIN(xb_ld(&bar[XB_TOPGEN]) == tg, bar);
            __builtin_amdgcn_fence(__ATOMIC_ACQUIRE, "agent");
            xb_add(&bar[XB_XGEN(b.x)], 1u);
            asm volatile("s_waitcnt vmcnt(0)" ::: "memory");
        } else {
            XB_SPIN(xb_ld(&bar[XB_XGEN(b.x)]) == gen, bar);
            __builtin_amdgcn_fence(__ATOMIC_ACQUIRE, "agent");
            asm volatile("s_waitcnt vmcnt(0)" ::: "memory");
        }
    }
    __syncthreads();
}

__device__ __forceinline__ int opq_tid() { int t = threadIdx.x; asm volatile("" : "+v"(t)); return t; }
namespace pg8 {
#define PG8_LAS __attribute__((address_space(3)))
typedef unsigned short bf16_t;
typedef short bf16x8 __attribute__((ext_vector_type(8)));
typedef float f32x4 __attribute__((ext_vector_type(4)));
typedef unsigned u32x4 __attribute__((ext_vector_type(4)));
constexpr int BM = 256, BK = 64, HALF = 128, HTB = HALF * BK * 2  , STAGE_BYTES = 8 * HTB, NXCD = 8, WGM = 8;

__host__ __device__ __forceinline__ int lds_byte(int r, int c) { const int st = (r >> 4) * 2 + (c >> 5), rr = r & 15, cc = c & 31, ob = rr * 64 + cc * 2; return st * 1024 + (ob ^ (((ob >> 9) & 1) << 5)); }
__host__ __device__ __forceinline__ void stage_rc(int b, int& R, int& C) { const int st = b / 1024, sb = b % 1024, swz = sb ^ (((sb >> 9) & 1) << 5); R = (st >> 1) * 16 + swz / 64; C = (st & 1) * 32 + (swz % 64) / 2; }
__host__ __device__ __forceinline__ int perm32(int rho) { const int n = rho >> 4, i = rho & 15; return 8 * (i >> 2) + 4 * n + (i & 3); }
struct Unit { int pm, pn; };
struct Gemm { const bf16_t* A; const bf16_t* Bt; int M, N, K, lda; };

struct StaticOrder {
    int nM, nN, nwg, G, c;
    __host__ __device__ void init(int M, int N, int G_, int c_) { nM = M / BM; nN = N / BM; nwg = nM * nN; G = G_; c = c_; }
    __host__ __device__ bool next(int i, Unit& u) const {
        const long L = (long)i * G + c; if (L >= nwg) return false;
        int wgid = (int)L; { const int q = nwg / NXCD, r = nwg % NXCD, xcd = wgid % NXCD, off = wgid / NXCD; wgid = (xcd < r ? xcd * (q + 1) : r * (q + 1) + (xcd - r) * q) + off; }
        const int nig = WGM * nN, gid = wgid / nig, fm = gid * WGM, gsz = (nM - fm) < WGM ? (nM - fm) : WGM;
        u.pm = fm + ((wgid % nig) % gsz); u.pn = (wgid % nig) / gsz; return true;
    }
    __device__ __forceinline__ void a_ready(const Unit&) const {}
    __device__ __forceinline__ void done(const Unit&) const {}
};
template <class Epi, class Sched, bool STAMP = false>
__device__ __forceinline__ void gemm_phase(PG8_LAS unsigned char* lds, const Gemm g, const Sched& S, const Epi& E, unsigned long long* stamps) {
    const int tid = opq_tid(), wid = __builtin_amdgcn_readfirstlane(tid >> 6), lane = tid & 63, wr = wid >> 2, wc = wid & 3, fr = lane & 15, fq = lane >> 4;
    const int K = g.K, nt = K / BK;
    int ts_lo = 0, ts_hi = 0, nts = 0; const unsigned long long rt_entry = STAMP ? (unsigned long long)0 : 0ull;
#define PG8_STAMP() do { if (STAMP && wid == 0 && nts < 64) { const unsigned long long _c = (unsigned long long)clock64(); \
        ts_lo = (lane == nts) ? (int)(unsigned)_c : ts_lo; ts_hi = (lane == nts) ? (int)(unsigned)(_c >> 32) : ts_hi; ++nts; } } while (0)
    PG8_STAMP();
    unsigned voffA[2], voffB[2];
#pragma unroll
    for (int i = 0; i < 2; ++i) { int R, C; stage_rc(tid * 16 + i * 8192, R, C); const int Rb = Epi::PERM ? ((R & ~31) + perm32(R & 31)) : R;
        voffA[i] = (unsigned)(R * g.lda + C) * 2u; voffB[i] = (unsigned)(Rb * K + C) * 2u; }
    const size_t kstep = (size_t)(BK * 2);
    const size_t hstep = (size_t)HALF * K * 2, hstepA = (size_t)HALF * g.lda * 2;
    const size_t tstep = 2 * hstep, tstepA = 2 * hstepA;
    const unsigned ldsw = (unsigned)wid * 1024u;
    const int aoff = lds_byte(wr * 64 + fr, fq * 8), boff = lds_byte(wc * 32 + fr, fq * 8);
#define PG8_SA(b, h) (((b) * 2 + (h)) * HTB)
#define PG8_SB(b, h) ((4 + (b) * 2 + (h)) * HTB)
#define PG8_STAGE(bufoff, gbase, voff) do { _Pragma("unroll") for (int _i = 0; _i < 2; ++_i) \
        __builtin_amdgcn_global_load_lds((const unsigned*)((const char*)(gbase) + (voff)[_i]), (PG8_LAS unsigned*)(lds + (bufoff) + ldsw + _i * 8192), 16, 0, 0); } while (0)
#define PG8_LDA(dst, b, h) do { _Pragma("unroll") for (int m = 0; m < 4; ++m) _Pragma("unroll") for (int k = 0; k < 2; ++k) dst[m][k] = *(const PG8_LAS bf16x8*)(lds + PG8_SA(b, h) + aoff + m * 2048 + k * 1024); } while (0)
#define PG8_LDB(dst, b, h) do { _Pragma("unroll") for (int n = 0; n < 2; ++n) _Pragma("unroll") for (int k = 0; k < 2; ++k) dst[n][k] = *(const PG8_LAS bf16x8*)(lds + PG8_SB(b, h) + boff + n * 2048 + k * 1024); } while (0)
#define PG8_MMA(ai, bj, At, Bt) do { __builtin_amdgcn_s_setprio(1); _Pragma("unroll") for (int m = 0; m < 4; ++m) _Pragma("unroll") for (int n = 0; n < 2; ++n) _Pragma("unroll") for (int k = 0; k < 2; ++k) \
        acc[ai][bj][m][n] = __builtin_amdgcn_mfma_f32_16x16x32_bf16(Bt[n][k], At[m][k], acc[ai][bj][m][n], 0, 0, 0); __builtin_amdgcn_s_setprio(0); } while (0)
#define PG8_WAIT_V(n) asm volatile("s_waitcnt vmcnt(" #n ")" ::: "memory")
#define PG8_WAIT_L(n) asm volatile("s_waitcnt lgkmcnt(" #n ")" ::: "memory")
#define PG8_BAR __builtin_amdgcn_s_barrier()
#define PG8_SCHED __builtin_amdgcn_sched_barrier(0)
    Unit cur, nxt; int ui = 0;
    if (!S.next(0, cur)) return;
    f32x4 acc[2][2][4][2];
#pragma unroll
    for (int a = 0; a < 2; ++a)
#pragma unroll
        for (int b = 0; b < 2; ++b)
#pragma unroll
            for (int m = 0; m < 4; ++m)
#pragma unroll
                for (int n = 0; n < 2; ++n) acc[a][b][m][n] = (f32x4){0.f, 0.f, 0.f, 0.f};
    bf16x8 At[4][2], B0[2][2], B1[2][2];
    const char* cA = (const char*)g.A + (size_t)cur.pm * tstepA; const char* cB = (const char*)g.Bt + (size_t)cur.pn * tstep;
    S.a_ready(cur);
    PG8_STAGE(PG8_SB(0, 0), cB, voffB); PG8_STAGE(PG8_SA(0, 0), cA, voffA); PG8_STAGE(PG8_SB(0, 1), cB + hstep, voffB); PG8_STAGE(PG8_SA(0, 1), cA + hstepA, voffA);
    if (wr == 1) PG8_BAR;
    PG8_WAIT_V(4); PG8_BAR;
    PG8_STAGE(PG8_SB(1, 0), cB + kstep, voffB); PG8_STAGE(PG8_SA(1, 0), cA + kstep, voffA); PG8_STAGE(PG8_SB(1, 1), cB + hstep + kstep, voffB);
    PG8_WAIT_V(6); PG8_BAR;
    PG8_STAMP();
    for (;;) {
        const bool has_next = S.next(ui + 1, nxt);
        const char* nA = has_next ? (const char*)g.A + (size_t)nxt.pm * tstepA : cA; const char* nB = has_next ? (const char*)g.Bt + (size_t)nxt.pn * tstep : cB;
        for (int t = 0; t < nt; t += 2) {
            const bool last = (t == nt - 2);
            const char* a1 = cA + (size_t)(t + 1) * kstep;
            const char* a2 = last ? nA : cA + (size_t)(t + 2) * kstep; const char* b2 = last ? nB : cB + (size_t)(t + 2) * kstep;
            const char* a3 = a2 + kstep; const char* b3 = b2 + kstep;
            if (last && has_next) S.a_ready(nxt);
            PG8_LDB(B0, 0, 0); PG8_SCHED; PG8_LDA(At, 0, 0); PG8_STAGE(PG8_SA(1, 1), a1 + hstepA, voffA);
            PG8_WAIT_L(8); PG8_BAR; PG8_WAIT_L(0); PG8_MMA(0, 0, At, B0); PG8_BAR; PG8_SCHED;
            PG8_LDB(B1, 0, 1); PG8_STAGE(PG8_SB(0, 0), b2, voffB);
            PG8_BAR; PG8_WAIT_L(0); PG8_MMA(0, 1, At, B1); PG8_BAR;
            PG8_LDA(At, 0, 1); PG8_STAGE(PG8_SA(0, 0), a2, voffA);
            PG8_BAR; PG8_WAIT_L(0); PG8_MMA(1, 0, At, B0); PG8_BAR; PG8_SCHED;
            PG8_STAGE(PG8_SB(0, 1), b2 + hstep, voffB);
            PG8_WAIT_V(6); PG8_BAR; PG8_MMA(1, 1, At, B1); PG8_BAR;
            PG8_LDB(B0, 1, 0); PG8_SCHED; PG8_LDA(At, 1, 0); PG8_STAGE(PG8_SA(0, 1), a2 + hstepA, voffA);
            PG8_WAIT_L(8); PG8_BAR; PG8_WAIT_L(0); PG8_MMA(0, 0, At, B0); PG8_BAR; PG8_SCHED;
            PG8_LDB(B1, 1, 1); PG8_STAGE(PG8_SB(1, 0), b3, voffB);
            PG8_BAR; PG8_WAIT_L(0); PG8_MMA(0, 1, At, B1); PG8_BAR;
            PG8_LDA(At, 1, 1); PG8_STAGE(PG8_SA(1, 0), a3, voffA);
            PG8_BAR; PG8_WAIT_L(0); PG8_MMA(1, 0, At, B0); PG8_BAR; PG8_SCHED;
            PG8_STAGE(PG8_SB(1, 1), b3 + hstep, voffB);
            PG8_WAIT_V(6); PG8_BAR; PG8_MMA(1, 1, At, B1); PG8_BAR;
        }
        PG8_STAMP();
        if constexpr (!Epi::AFTER_DRAIN) { E(acc, cur, wr, wc, fr, fq); S.done(cur); }
        PG8_STAMP();
        if (!has_next) break;
#pragma unroll
        for (int a = 0; a < 2; ++a)
#pragma unroll
            for (int b = 0; b < 2; ++b)
#pragma unroll
                for (int m = 0; m < 4; ++m)
#pragma unroll
                    for (int n = 0; n < 2; ++n) acc[a][b][m][n] = (f32x4){0.f, 0.f, 0.f, 0.f};
        cur = nxt; cA = nA; cB = nB; ++ui;
    }
    PG8_WAIT_V(0);
    if (wr == 0) PG8_BAR;
    PG8_BAR;
    if constexpr (Epi::AFTER_DRAIN) { E.fused(acc, cur, wr, wc, fr, fq, lds, wid, lane); S.done(cur); }
    PG8_STAMP();
    if (STAMP && wid == 0) { stamps[lane] = lane < nts ? (((unsigned long long)(unsigned)ts_hi << 32) | (unsigned)ts_lo) : 0ull;
        if (lane == 62) stamps[62] = rt_entry; if (lane == 63) stamps[63] = (unsigned long long)0; }
#undef PG8_STAMP
#undef PG8_SA
#undef PG8_SB
#undef PG8_STAGE
#undef PG8_LDA
#undef PG8_LDB
#undef PG8_MMA
#undef PG8_WAIT_V
#undef PG8_WAIT_L
#undef PG8_BAR
#undef PG8_SCHED
}
}

typedef unsigned short bf16_t;
typedef short bf16x8 __attribute__((ext_vector_type(8)));
typedef float f32x4 __attribute__((ext_vector_type(4)));
typedef unsigned u32x4 __attribute__((ext_vector_type(4)));
typedef unsigned u32x2 __attribute__((ext_vector_type(2)));
#define DEV __device__ __forceinline__

constexpr int MTOK = 32768, DM = 1024, SEQ = 8192;
constexpr int LDE = 5376, LDO = 3072, LDF = 5632;
constexpr size_t MiB = (size_t)1 << 20;
constexpr size_t OFF_P = 0, OFF_HB = 352 * MiB, OFF_WT = 416 * MiB;
constexpr size_t W_INE = 0, W_OUTE = W_INE + (size_t)5376 * 1024, W_INO = W_OUTE + (size_t)1024 * 1024, W_OUTO = W_INO + (size_t)3072 * 1024,
                 W_UP0 = W_OUTO + (size_t)1024 * 1024, W_UP1 = W_UP0 + (size_t)5632 * 1024, W_DN0 = W_UP1 + (size_t)5632 * 1024, W_DN1 = W_DN0 + (size_t)1024 * 2816;
constexpr size_t OFF_THIN = 470 * MiB, OFF_HALO1 = OFF_THIN + 2 * MiB, OFF_HALO2 = OFF_HALO1 + 7 * MiB, OFF_GAM = OFF_HALO2 + 6 * MiB, OFF_BETA = OFF_GAM + MiB,
                 OFF_LSE = OFF_BETA + MiB, OFF_BLUT = OFF_LSE + 2 * MiB, OFF_CNT = OFF_BLUT + 32768, OFF_LAM = OFF_CNT + 256, OFF_BAR = OFF_LAM + 256, OFF_PARAMS = OFF_BAR + 16384, WS_NEED = OFF_PARAMS + 256;
constexpr float DN_ALPHA = 1.4142135623730951f;
constexpr float LAM_INIT = 0.35550906759f;
constexpr float LOG2E = 1.4426950408889634f;
constexpr int NLUT = 1536;

struct Params {
    const float *x, *rel_bias, *w_in_even, *gdn_conv_w, *gdn_a_log, *gdn_dt_bias, *gdn_norm_w, *w_out_even, *w_in_odd, *diff_lambda, *diff_norm_w, *gla_w_gate,
        *gla_b_gate, *gla_norm_w, *w_out_odd, *ffn_w_up, *ffn_conv_w, *ffn_conv_b, *ffn_w_down, *ln_g, *ln_b;
    float* out; unsigned char* ws;
};

DEV const void* gparam(const unsigned char* ws, int idx) {
    const unsigned long long v = ((const unsigned long long*)(ws + OFF_PARAMS))[idx];
    const unsigned lo = __builtin_amdgcn_readfirstlane((unsigned)v), hi = __builtin_amdgcn_readfirstlane((unsigned)(v >> 32));
    return (const void*)(((unsigned long long)hi << 32) | lo);
}
DEV Params load_params(unsigned char* ws) {
    Params q;
    const float** f = (const float**)&q;
#pragma unroll
    for (int i = 0; i < 21; ++i) f[i] = (const float*)gparam(ws, i);
    q.out = (float*)gparam(ws, 21); q.ws = ws;
    return q;
}
DEV float lo2f(unsigned w) { return __uint_as_float(w << 16); }
DEV float hi2f(unsigned w) { return __uint_as_float(w & 0xffff0000u); }
DEV float bf2f(bf16_t b) { return __uint_as_float(((unsigned)b) << 16); }
typedef __bf16 bf16v2_t __attribute__((ext_vector_type(2)));
typedef float f32v2_t __attribute__((ext_vector_type(2)));
DEV unsigned pk2(float lo, float hi) { const f32v2_t v = {lo, hi}; const bf16v2_t b = __builtin_convertvector(v, bf16v2_t); return __builtin_bit_cast(unsigned, b); }
DEV bf16_t f2bf(float f) { return (bf16_t)(pk2(f, 0.f) & 0xffffu); }
DEV bf16x8 mk8(unsigned a, unsigned b, unsigned c, unsigned d) { u32x4 v = {a, b, c, d}; return __builtin_bit_cast(bf16x8, v); }
DEV f32x4 mfma16(bf16x8 a, bf16x8 b, f32x4 c) { return __builtin_amdgcn_mfma_f32_16x16x32_bf16(a, b, c, 0, 0, 0); }
DEV bf16x8 ld8(const bf16_t* p) { return *(const bf16x8*)p; }
DEV bf16x8 ldperm(const bf16_t* p) { const u32x2 lo = *(const u32x2*)p, hi = *(const u32x2*)(p + 16); return mk8(lo.x, lo.y, hi.x, hi.y); }
DEV bf16x8 pk8(f32x4 a, f32x4 b) { return mk8(pk2(a[0], a[1]), pk2(a[2], a[3]), pk2(b[0], b[1]), pk2(b[2], b[3])); }
DEV float silu(float x) { return x * __builtin_amdgcn_rcpf(1.0f + __expf(-x)); }
DEV float ex2(float x) { return __builtin_amdgcn_exp2f(x); }
DEV float dpp_f(float v, int ctrl_b1) { return v; }
DEV float rsum16(float v) {
    v += __int_as_float(__builtin_amdgcn_update_dpp(0, __float_as_int(v), 0xB1, 0xf, 0xf, true));
    v += __int_as_float(__builtin_amdgcn_update_dpp(0, __float_as_int(v), 0x4E, 0xf, 0xf, true));
    v += __int_as_float(__builtin_amdgcn_update_dpp(0, __float_as_int(v), 0x141, 0xf, 0xf, true));
    v += __int_as_float(__builtin_amdgcn_update_dpp(0, __float_as_int(v), 0x140, 0xf, 0xf, true));
    return v;
}
DEV float wsum(float v) { v = rsum16(v); v += __shfl_xor(v, 16); v += __shfl_xor(v, 32); return v; }

struct EpiStoreBf16 {
    static constexpr bool PERM = true, AFTER_DRAIN = false;
    bf16_t* O; int ldc; bf16_t* halo; int seg, hrows, hcols;
    __device__ __forceinline__ void operator()(const f32x4 (&acc)[2][2][4][2], const pg8::Unit& u, int wr, int wc, int fr, int fq) const {
        const int row0 = u.pm * 256 + wr * 64 + fr, col0 = u.pn * 256 + wc * 32 + 8 * fq;
#pragma unroll
        for (int ai = 0; ai < 2; ++ai)
#pragma unroll
            for (int m = 0; m < 4; ++m) {
                const int row = row0 + ai * 128 + m * 16; bf16_t* rowp = O + (size_t)row * ldc + col0;
                const int rs = row & (seg - 1); const bool hal = rs >= seg - hrows;
#pragma unroll
                for (int bj = 0; bj < 2; ++bj) {
                    const f32x4 v0 = acc[ai][bj][m][0], v1 = acc[ai][bj][m][1];
                    u32x4 w; w.x = pk2(v0[0], v0[1]); w.y = pk2(v0[2], v0[3]); w.z = pk2(v1[0], v1[1]); w.w = pk2(v1[2], v1[3]);
                    *(u32x4*)(rowp + bj * 128) = w;
                    if (hal && col0 + bj * 128 < hcols) *(u32x4*)(halo + ((size_t)(row / seg) * hrows + (rs - (seg - hrows))) * hcols + col0 + bj * 128) = w;
                }
            }
    }
};
struct EpiResF32 {
    static constexpr bool PERM = false, AFTER_DRAIN = false;
    const float* base; float* out; int ldc; float alpha;
    __device__ __forceinline__ void operator()(const f32x4 (&acc)[2][2][4][2], const pg8::Unit& u, int wr, int wc, int fr, int fq) const {
        const int row0 = u.pm * 256 + wr * 64 + fr, col0 = u.pn * 256 + wc * 32 + 4 * fq;
#pragma unroll
        for (int ai = 0; ai < 2; ++ai)
#pragma unroll
            for (int mp = 0; mp < 2; ++mp) {
                f32x4 bs[2][2][2];
#pragma unroll
                for (int mm = 0; mm < 2; ++mm) {
                    const size_t off = (size_t)(row0 + ai * 128 + (2 * mp + mm) * 16) * ldc + col0;
#pragma unroll
                    for (int bj = 0; bj < 2; ++bj)
#pragma unroll
                        for (int n = 0; n < 2; ++n) bs[mm][bj][n] = *(const f32x4*)(base + off + bj * 128 + n * 16);
                }
#pragma unroll
                for (int mm = 0; mm < 2; ++mm) {
                    const size_t off = (size_t)(row0 + ai * 128 + (2 * mp + mm) * 16) * ldc + col0;
#pragma unroll
                    for (int bj = 0; bj < 2; ++bj)
#pragma unroll
                        for (int n = 0; n < 2; ++n) *(f32x4*)(out + off + bj * 128 + n * 16) = bs[mm][bj][n] * alpha + acc[ai][bj][2 * mp + mm][n];
                }
                asm volatile("" ::: "memory");
            }
    }
};
template <class Epi> DEV void run_gemm(const bf16_t* A, int lda, const bf16_t* Bt, int M, int N, int K, const Epi& E) {
    pg8::Gemm g; g.A = A; g.Bt = Bt; g.M = M; g.N = N; g.K = K; g.lda = lda;
    pg8::StaticOrder S; S.init(M, N, (int)gridDim.x, (int)blockIdx.x);
    pg8::gemm_phase<Epi, pg8::StaticOrder, false>((PG8_LAS unsigned char*)g_shm, g, S, E, nullptr);
}

DEV void cvt_tile(const float* src, int ld, int K, int srcn0, int k0, bf16_t* dst, int dstn0) {
    float* tile = (float*)g_shm; const int tid = opq_tid();
#pragma unroll
    for (int i = 0; i < 2; ++i) { const int idx = tid + 512 * i, kk = idx >> 4, n4 = (idx & 15) * 4; const float4 v = *(const float4*)(src + (size_t)(k0 + kk) * ld + srcn0 + n4);
        tile[kk * 65 + n4] = v.x; tile[kk * 65 + n4 + 1] = v.y; tile[kk * 65 + n4 + 2] = v.z; tile[kk * 65 + n4 + 3] = v.w; }
    __syncthreads();
    { const int n = tid >> 3, k8 = (tid & 7) * 8; float v[8];
#pragma unroll
      for (int j = 0; j < 8; ++j) v[j] = tile[(k8 + j) * 65 + n];
      u32x4 w; w.x = pk2(v[0], v[1]); w.y = pk2(v[2], v[3]); w.z = pk2(v[4], v[5]); w.w = pk2(v[6], v[7]);
      *(u32x4*)(dst + (size_t)(dstn0 + n) * K + k0 + k8) = w; }
    __syncthreads();
}
DEV void cvt_weight_tile(const Params& p, int t) {
    bf16_t* WT = (bf16_t*)(p.ws + OFF_WT);
    {
        const float* src; int ld, K, nt; bf16_t* dst; int shift = 0; int lt = t;
        if (lt < 1344) { src = p.w_in_even; ld = 5388; K = 1024; nt = 84; dst = WT + W_INE; shift = 12; }
        else if ((lt -= 1344) < 256) { src = p.w_out_even; ld = 1024; K = 1024; nt = 16; dst = WT + W_OUTE; }
        else if ((lt -= 256) < 768) { src = p.w_in_odd; ld = 3088; K = 1024; nt = 48; dst = WT + W_INO; }
        else if ((lt -= 768) < 256) { src = p.w_out_odd; ld = 1024; K = 1024; nt = 16; dst = WT + W_OUTO; }
        else if ((lt -= 256) < 1408) { src = p.ffn_w_up; ld = 5632; K = 1024; nt = 88; dst = WT + W_UP0; }
        else if ((lt -= 1408) < 1408) { src = p.ffn_w_up + (size_t)1024 * 5632; ld = 5632; K = 1024; nt = 88; dst = WT + W_UP1; }
        else if ((lt -= 1408) < 704) { src = p.ffn_w_down; ld = 1024; K = 2816; nt = 16; dst = WT + W_DN0; }
        else { lt -= 704; src = p.ffn_w_down + (size_t)2816 * 1024; ld = 1024; K = 2816; nt = 16; dst = WT + W_DN1; }
        const int ntile = lt % nt, ktile = lt / nt; const int n0 = ntile * 64; const int srcn0 = (n0 >= 3072) ? n0 + shift : n0;
        cvt_tile(src, ld, K, srcn0, ktile * 64, dst, n0);
    }
}
DEV void phase_weights(const Params& p) {
#pragma unroll 1
    for (int t = blockIdx.x; t < 1600; t += gridDim.x) cvt_weight_tile(p, t);
    if (blockIdx.x == 0) {
        if (threadIdx.x < 22) { const void* const* src = (const void* const*)&p; ((const void**)(p.ws + OFF_PARAMS))[threadIdx.x] = src[threadIdx.x]; }
        float* blut = (float*)(p.ws + OFF_BLUT);
        for (int d = threadIdx.x; d < NLUT; d += 512) {
            int bk;
            if (d < 16) bk = d; else { const float lg = logf((float)d / 16.0f) / 4.852030263919617f * 16.0f; bk = 16 + (int)lg; if (bk > 31) bk = 31; }
            for (int h = 0; h < 4; ++h) blut[h * NLUT + d] = p.rel_bias[bk * 4 + h];
        }
        if (threadIdx.x == 0) {
            float s1 = 0.f, s2 = 0.f; for (int i = 0; i < 64; ++i) { s1 += p.diff_lambda[i] * p.diff_lambda[64 + i]; s2 += p.diff_lambda[128 + i] * p.diff_lambda[192 + i]; }
            *(float*)(p.ws + OFF_LAM) = expf(s1) - expf(s2) + LAM_INIT;
            *(unsigned*)(p.ws + OFF_CNT) = 0u; *(unsigned*)(p.ws + OFF_CNT + 64) = 0u; *(unsigned*)(p.ws + OFF_CNT + 128) = 0u;
        }
    }
}

DEV void rowpass(const float* src, const bf16_t* mix, float* dst, bf16_t* hb, const float* lg, const float* lb, const float* wthin, int ldw, int nc, float* thin) {
    float* W = (float*)g_shm; const int tid = opq_tid(), wid = tid >> 6, lane = tid & 63;
    __syncthreads();
    if (nc > 0) {
        for (int idx = tid; idx < 16384; idx += 512) { const int k = idx >> 4, c = idx & 15; const int i = k >> 8, ln = (k & 255) >> 2, j = k & 3, c4 = c >> 2, cc = c & 3;
            W[((((i * 4 + j) * 4 + c4) * 64 + ln) * 4) + cc] = c < nc ? wthin[(size_t)k * ldw + c] : 0.f; }
    }
    __syncthreads();
    f32x4 v[4], vn[4]; u32x2 mn[4];
    {
        const int r0 = blockIdx.x * 8 + wid;
#pragma unroll
        for (int i = 0; i < 4; ++i) { vn[i] = (f32x4){0.f, 0.f, 0.f, 0.f}; mn[i] = (u32x2){0u, 0u}; if (r0 < MTOK) { vn[i] = *(const f32x4*)(src + (size_t)r0 * DM + i * 256 + lane * 4);
            if (mix) mn[i] = *(const u32x2*)(mix + (size_t)r0 * LDF + i * 256 + lane * 4); } }
    }
#pragma unroll 1
    for (int rb = blockIdx.x * 8 + wid; rb < MTOK; rb += gridDim.x * 8) {
        const int r = rb, rn = rb + (int)gridDim.x * 8;
#pragma unroll
        for (int i = 0; i < 4; ++i) { v[i] = vn[i]; if (mix) { v[i] = v[i] * DN_ALPHA + (f32x4){lo2f(mn[i].x), hi2f(mn[i].x), lo2f(mn[i].y), hi2f(mn[i].y)}; } }
        if (rn < MTOK) {
#pragma unroll
            for (int i = 0; i < 4; ++i) { vn[i] = *(const f32x4*)(src + (size_t)rn * DM + i * 256 + lane * 4); if (mix) mn[i] = *(const u32x2*)(mix + (size_t)rn * LDF + i * 256 + lane * 4); }
        }
        if (lg) {
            float s = 0.f;
#pragma unroll
            for (int i = 0; i < 4; ++i) s += (v[i][0] + v[i][1]) + (v[i][2] + v[i][3]);
            const float mu = wsum(s) * (1.0f / 1024.0f); float q = 0.f;
#pragma unroll
            for (int i = 0; i < 4; ++i) { const f32x4 d = v[i] - mu; q += (d[0] * d[0] + d[1] * d[1]) + (d[2] * d[2] + d[3] * d[3]); }
            const float rstd = rsqrtf(wsum(q) * (1.0f / 1024.0f) + 1e-5f);
#pragma unroll
            for (int i = 0; i < 4; ++i) { const f32x4 gg = *(const f32x4*)(lg + i * 256 + lane * 4), bb = *(const f32x4*)(lb + i * 256 + lane * 4); v[i] = (v[i] - mu) * rstd * gg + bb; }
        }
#pragma unroll
        for (int i = 0; i < 4; ++i) {
            if (dst) *(f32x4*)(dst + (size_t)r * DM + i * 256 + lane * 4) = v[i];
            if (hb) { u32x2 w; w.x = pk2(v[i][0], v[i][1]); w.y = pk2(v[i][2], v[i][3]); *(u32x2*)(hb + (size_t)r * DM + i * 256 + lane * 4) = w; }
        }
        if (nc > 0) {
            f32x4 a4[4];
#pragma unroll
            for (int c4 = 0; c4 < 4; ++c4) a4[c4] = (f32x4){0.f, 0.f, 0.f, 0.f};
#pragma unroll
            for (int i = 0; i < 4; ++i)
#pragma unroll
                for (int j = 0; j < 4; ++j) {
                    const float yv = v[i][j];
#pragma unroll
                    for (int c4 = 0; c4 < 4; ++c4) a4[c4] += *(const f32x4*)(W + (((i * 4 + j) * 4 + c4) * 64 + lane) * 4) * yv;
                    asm volatile("" ::: "memory");
                }
#pragma unroll
            for (int c4 = 0; c4 < 4; ++c4)
#pragma unroll
                for (int cc = 0; cc < 4; ++cc) { const float t = wsum(a4[c4][cc]); if (lane == c4 * 4 + cc) thin[(size_t)r * 16 + lane] = t; }
        }
    }
    __syncthreads();
}

DEV void convgate(const Params& p, int layer) {
    bf16_t* P = (bf16_t*)(p.ws + OFF_P); const bf16_t* halo = (const bf16_t*)(p.ws + OFF_HALO2);
    const float* cw = p.ffn_conv_w + (size_t)layer * 3 * 5632; const float* cb = p.ffn_conv_b + (size_t)layer * 5632;
    const int tid = opq_tid();
    if (tid >= 352) return;
    const int c0 = tid * 8;
    float wg[3][8], wv[3][8], bg[8], bv[8];
#pragma unroll
    for (int j = 0; j < 3; ++j)
#pragma unroll
        for (int e = 0; e < 8; ++e) { wg[j][e] = cw[j * 5632 + c0 + e]; wv[j][e] = cw[j * 5632 + 2816 + c0 + e]; }
#pragma unroll
    for (int e = 0; e < 8; ++e) { bg[e] = cb[c0 + e]; bv[e] = cb[2816 + c0 + e]; }
#pragma unroll 1
    for (int seg = blockIdx.x; seg < 256; seg += gridDim.x) {
        u32x4 g1, g2, v1, v2;
        if ((seg & 63) == 0) { g1 = g2 = v1 = v2 = (u32x4){0u, 0u, 0u, 0u}; }
        else { const bf16_t* hp = halo + (size_t)(seg - 1) * 2 * 5632; g1 = *(const u32x4*)(hp + c0); v1 = *(const u32x4*)(hp + 2816 + c0); g2 = *(const u32x4*)(hp + 5632 + c0); v2 = *(const u32x4*)(hp + 5632 + 2816 + c0); }
        bf16_t* base = P + (size_t)seg * 128 * LDF;
#pragma unroll 1
        for (int t4 = 0; t4 < 128; t4 += 8) {
            u32x4 gr[8], vr[8];
#pragma unroll
            for (int q = 0; q < 8; ++q) { gr[q] = *(const u32x4*)(base + (size_t)(t4 + q) * LDF + c0); vr[q] = *(const u32x4*)(base + (size_t)(t4 + q) * LDF + 2816 + c0); }
#pragma unroll
            for (int q = 0; q < 8; ++q) {
                const u32x4 g3 = gr[q], v3 = vr[q]; u32x4 o;
#pragma unroll
                for (int w = 0; w < 4; ++w) {
                    const float G0 = wg[0][2 * w] * lo2f(g1[w]) + wg[1][2 * w] * lo2f(g2[w]) + wg[2][2 * w] * lo2f(g3[w]) + bg[2 * w];
                    const float G1 = wg[0][2 * w + 1] * hi2f(g1[w]) + wg[1][2 * w + 1] * hi2f(g2[w]) + wg[2][2 * w + 1] * hi2f(g3[w]) + bg[2 * w + 1];
                    const float V0 = wv[0][2 * w] * lo2f(v1[w]) + wv[1][2 * w] * lo2f(v2[w]) + wv[2][2 * w] * lo2f(v3[w]) + bv[2 * w];
                    const float V1 = wv[0][2 * w + 1] * hi2f(v1[w]) + wv[1][2 * w + 1] * hi2f(v2[w]) + wv[2][2 * w + 1] * hi2f(v3[w]) + bv[2 * w + 1];
                    o[w] = pk2(silu(G0) * V0, silu(G1) * V1);
                }
                *(u32x4*)(base + (size_t)(t4 + q) * LDF + c0) = o;
                g1 = g2; g2 = g3; v1 = v2; v2 = v3;
            }
        }
    }
}

template <int BASE> DEV void solve32(const float* As, float* Tm, int lane) {
    const int c = lane & 31;
    float t[32];
#pragma unroll
    for (int i = 0; i < 32; ++i) t[i] = 0.f;
#pragma unroll
    for (int i = 0; i < 32; ++i) {
        float sv = (i == c) ? 1.f : 0.f;
#pragma unroll
        for (int j4 = 0; j4 < (i + 3) / 4; ++j4) { const f32x4 a = *(const f32x4*)(As + (BASE + i) * 68 + BASE + j4 * 4);
            sv -= a[0] * t[4 * j4]; sv -= a[1] * t[4 * j4 + 1]; sv -= a[2] * t[4 * j4 + 2]; sv -= a[3] * t[4 * j4 + 3]; }
        t[i] = sv;
        if (lane < 32) { Tm[(BASE + i) * 68 + BASE + c] = sv; if (BASE == 0) Tm[i * 68 + 32 + c] = 0.f; }
        asm volatile("" ::: "memory");
    }
}

DEV void gdn_prep(const Params& p) {
    bf16_t* P = (bf16_t*)(p.ws + OFF_P);
    const float* thin = (const float*)(p.ws + OFF_THIN);
    const bf16_t* halo = (const bf16_t*)(p.ws + OFF_HALO1);
    float* gamG = (float*)(p.ws + OFF_GAM); float* betaG = (float*)(p.ws + OFF_BETA);
    bf16_t* Tg = (bf16_t*)p.out; bf16_t* QKg = Tg + (size_t)3072 * 4096; bf16_t* kTg = QKg + (size_t)3072 * 4096;
    bf16_t* Qs = (bf16_t*)g_shm; bf16_t* Ks = Qs + 64 * 136; float* As = (float*)(g_shm + 2 * 17408); float* gamS = As + 64 * 68; float* betaS = gamS + 64;
#pragma unroll 1
    for (int it0 = blockIdx.x; it0 < 3072; it0 += gridDim.x) {
        const int tid = opq_tid(), wid = tid >> 6, lane = tid & 63, fr = lane & 15, fq = lane >> 4;
        const int h = it0 % 6, bn = it0 / 6, n = bn & 127, b = bn >> 7;
        const int item = (b * 6 + h) * 128 + n;
        const int t0 = b * SEQ + n * 64;
        u32x4 keep[6];
#pragma unroll
        for (int u6 = 0; u6 < 6; ++u6) {
            const int mat = u6 >> 1, r = (u6 & 1) * 32 + (tid >> 4), cg8 = (tid & 15) * 8;
            const int col = mat * 768 + h * 128 + cg8;
            float y[8];
#pragma unroll
            for (int e = 0; e < 8; ++e) y[e] = 0.f;
#pragma unroll
            for (int j = 0; j < 4; ++j) {
                const int rr = r - 3 + j;
                u32x4 raw = (u32x4){0u, 0u, 0u, 0u};
                if (rr >= 0) raw = *(const u32x4*)(P + (size_t)(t0 + rr) * LDE + col);
                else if (n > 0) raw = *(const u32x4*)(halo + ((size_t)(b * 128 + n - 1) * 3 + (rr + 3)) * 2304 + col);
                const f32x4 w0 = *(const f32x4*)(p.gdn_conv_w + j * 2304 + col), w1 = *(const f32x4*)(p.gdn_conv_w + j * 2304 + col + 4);
                y[0] += w0[0] * lo2f(raw.x); y[1] += w0[1] * hi2f(raw.x); y[2] += w0[2] * lo2f(raw.y); y[3] += w0[3] * hi2f(raw.y);
                y[4] += w1[0] * lo2f(raw.z); y[5] += w1[1] * hi2f(raw.z); y[6] += w1[2] * lo2f(raw.w); y[7] += w1[3] * hi2f(raw.w);
            }
            float ss = 0.f;
#pragma unroll
            for (int e = 0; e < 8; ++e) { y[e] = silu(y[e]); ss += y[e] * y[e]; }
            if (mat < 2) {
                ss = rsum16(ss);
                const float inv = rsqrtf(ss + 1e-6f) * (mat == 0 ? 0.08838834764831845f : 1.0f);
#pragma unroll
                for (int e = 0; e < 8; ++e) y[e] *= inv;
            }
            u32x4 w; w.x = pk2(y[0], y[1]); w.y = pk2(y[2], y[3]); w.z = pk2(y[4], y[5]); w.w = pk2(y[6], y[7]);
            keep[u6] = w;
            if (mat == 0) *(u32x4*)(Qs + r * 136 + cg8) = w;
            if (mat == 1) *(u32x4*)(Ks + r * 136 + cg8) = w;
        }
        if (wid == 0) {
            const int t = t0 + lane;
            const float ba = thin[(size_t)t * 16 + h], aa = thin[(size_t)t * 16 + 6 + h];
            const float beta = 1.0f / (1.0f + expf(-ba));
            const float xx = aa + p.gdn_dt_bias[h];
            const float sp = xx > 20.f ? xx : log1pf(expf(xx));
            float g = -expf(p.gdn_a_log[h]) * sp;
#pragma unroll
            for (int o = 1; o < 64; o <<= 1) { const float tt = __shfl_up(g, o); if (lane >= o) g += tt; }
            gamS[lane] = g; betaS[lane] = beta;
            gamG[(size_t)(b * 6 + h) * SEQ + n * 64 + lane] = g; betaG[(size_t)(b * 6 + h) * SEQ + n * 64 + lane] = beta;
        }
        __syncthreads();
        {
            const int mtx = wid >> 2, itile = wid & 3; const bf16_t* X = mtx ? Qs : Ks;
#pragma unroll
            for (int jt = 0; jt < 4; ++jt) {
                f32x4 acc = (f32x4){0.f, 0.f, 0.f, 0.f};
                if (jt <= itile) {
#pragma unroll
                    for (int kb = 0; kb < 4; ++kb) acc = mfma16(ld8(X + (16 * itile + fr) * 136 + kb * 32 + fq * 8), ld8(Ks + (16 * jt + fr) * 136 + kb * 32 + fq * 8), acc);
                }
#pragma unroll
                for (int jj = 0; jj < 4; ++jj) {
                    const int i = 16 * itile + 4 * fq + jj, j = 16 * jt + fr;
                    const float dec = (i >= j) ? __expf(gamS[i] - gamS[j]) : 0.f;
                    if (mtx == 0) As[i * 68 + j] = (i > j) ? betaS[i] * acc[jj] * dec : 0.f;
                    else QKg[(size_t)item * 4096 + i * 64 + j] = f2bf(acc[jj] * dec);
                }
            }
        }
        __syncthreads();
#pragma unroll
        for (int u6 = 0; u6 < 6; ++u6) {
            const int mat = u6 >> 1, r = (u6 & 1) * 32 + (tid >> 4), cg8 = (tid & 15) * 8;
            *(u32x4*)(P + (size_t)(t0 + r) * LDE + mat * 768 + h * 128 + cg8) = keep[u6];
        }
        {
            const int dk = tid >> 2, c0 = (tid & 3) * 16; unsigned w[8];
#pragma unroll
            for (int e = 0; e < 8; ++e) w[e] = (unsigned)Ks[(c0 + 2 * e) * 136 + dk] | ((unsigned)Ks[(c0 + 2 * e + 1) * 136 + dk] << 16);
            u32x4 a = {w[0], w[1], w[2], w[3]}, bq = {w[4], w[5], w[6], w[7]};
            *(u32x4*)(kTg + (size_t)item * 8192 + dk * 64 + c0) = a; *(u32x4*)(kTg + (size_t)item * 8192 + dk * 64 + c0 + 8) = bq;
        }
        {
            float* Tm = betaS + 64; float* Xm = Tm + 64 * 68;
            if (wid == 0) solve32<0>(As, Tm, lane);
            else if (wid == 1) solve32<32>(As, Tm, lane);
            __syncthreads();
            {
                const int i = tid >> 4, c0 = (tid & 15) * 2; float x0 = 0.f, x1 = 0.f;
#pragma unroll 8
                for (int j = 0; j < 32; ++j) { const float a = As[(32 + i) * 68 + j]; x0 += a * Tm[j * 68 + c0]; x1 += a * Tm[j * 68 + c0 + 1]; }
                Xm[i * 36 + c0] = x0; Xm[i * 36 + c0 + 1] = x1;
            }
            __syncthreads();
            {
                const int i = tid >> 4, c0 = (tid & 15) * 2; float x0 = 0.f, x1 = 0.f;
#pragma unroll 8
                for (int j = 0; j < 32; ++j) { const float a = Tm[(32 + i) * 68 + 32 + j]; x0 -= a * Xm[j * 36 + c0]; x1 -= a * Xm[j * 36 + c0 + 1]; }
                Tm[(32 + i) * 68 + c0] = x0; Tm[(32 + i) * 68 + c0 + 1] = x1;
            }
            __syncthreads();
            {
                const int row = tid >> 3, col = (tid & 7) * 8; const f32x4 a = *(const f32x4*)(Tm + row * 68 + col), b2 = *(const f32x4*)(Tm + row * 68 + col + 4);
                u32x4 w; w.x = pk2(a[0], a[1]); w.y = pk2(a[2], a[3]); w.z = pk2(b2[0], b2[1]); w.w = pk2(b2[2], b2[3]);
                *(u32x4*)(Tg + (size_t)item * 4096 + tid * 8) = w;
            }
        }
        __syncthreads();
    }
}

DEV void gdn_scan(const Params& p, int task) {
    const bf16_t* P = (const bf16_t*)(p.ws + OFF_P);
    const float* gamG = (const float*)(p.ws + OFF_GAM); const float* betaG = (const float*)(p.ws + OFF_BETA);
    const bf16_t* Tg = (const bf16_t*)p.out; const bf16_t* QKg = Tg + (size_t)3072 * 4096; const bf16_t* kTg = QKg + (size_t)3072 * 4096;
    bf16_t* mo = (bf16_t*)(p.ws + OFF_HB);
    bf16_t* Kc = (bf16_t*)g_shm; bf16_t* Qc = Kc + 64 * 136; bf16_t* KT = Qc + 64 * 136; bf16_t* Tm = KT + 128 * 72; bf16_t* QK = Tm + 64 * 72; float* gamS = (float*)(QK + 64 * 72); float* betaS = gamS + 64; bf16_t* Vs = (bf16_t*)(betaS + 64);
    const int tid = opq_tid(), wid = tid >> 6, lane = tid & 63, fr = lane & 15, fq = lane >> 4;
    const int bh = task >> 2, quarter = task & 3, b = bh / 6, h = bh % 6;
    const size_t tok0 = (size_t)b * SEQ;
    const int dv = quarter * 32 + (wid & 1) * 16 + fr;
    u32x4 rK[2], rQ[2], rKT[2], rT, rQK, rV = (u32x4){0u, 0u, 0u, 0u}; float rg = 0.f, rb = 0.f;
    f32x4 S[8];
#pragma unroll
    for (int t = 0; t < 8; ++t) S[t] = (f32x4){0.f, 0.f, 0.f, 0.f};
#define GDN_LOAD(n_) do { const int n__ = (n_); const size_t item__ = (size_t)bh * 128 + n__; \
        _Pragma("unroll") for (int i = 0; i < 2; ++i) { const int idx = tid + 512 * i, r = idx >> 4, c8 = (idx & 15) * 8; \
            rK[i] = *(const u32x4*)(P + (tok0 + n__ * 64 + r) * LDE + 768 + h * 128 + c8); rQ[i] = *(const u32x4*)(P + (tok0 + n__ * 64 + r) * LDE + h * 128 + c8); \
            rKT[i] = *(const u32x4*)(kTg + item__ * 8192 + (size_t)idx * 8); } \
        rT = *(const u32x4*)(Tg + item__ * 4096 + (size_t)tid * 8); rQK = *(const u32x4*)(QKg + item__ * 4096 + (size_t)tid * 8); \
        if (tid < 256) rV = *(const u32x4*)(P + (tok0 + n__ * 64 + (tid >> 2)) * LDE + 1536 + h * 128 + quarter * 32 + (tid & 3) * 8); \
        if (tid < 64) { rg = gamG[(size_t)bh * SEQ + n__ * 64 + tid]; rb = betaG[(size_t)bh * SEQ + n__ * 64 + tid]; } } while (0)
#define GDN_STORE() do { \
        _Pragma("unroll") for (int i = 0; i < 2; ++i) { const int idx = tid + 512 * i, r = idx >> 4, c8 = (idx & 15) * 8; \
            *(u32x4*)(Kc + r * 136 + c8) = rK[i]; *(u32x4*)(Qc + r * 136 + c8) = rQ[i]; *(u32x4*)(KT + (idx >> 3) * 72 + (idx & 7) * 8) = rKT[i]; } \
        *(u32x4*)(Tm + (tid >> 3) * 72 + (tid & 7) * 8) = rT; *(u32x4*)(QK + (tid >> 3) * 72 + (tid & 7) * 8) = rQK; \
        if (tid < 256) *(u32x4*)(Vs + (tid >> 2) * 40 + (tid & 3) * 8) = rV; \
        if (tid < 64) { gamS[tid] = rg; betaS[tid] = rb; egS[tid] = __expf(rg); edS[tid] = __expf(__int_as_float(__builtin_amdgcn_readlane(__float_as_int(rg), 63)) - rg); } } while (0)
    bf16x8* exS = (bf16x8*)(Vs + 64 * 40);
    bf16x8* exD = exS + 2 * 4 * 64;
    float* egS = (float*)(exD + 2 * 2 * 64); float* edS = egS + 64;
    const int slice = wid & 1;
    __syncthreads();
    GDN_LOAD(0); GDN_STORE();
    if (wid < 2) {
#pragma unroll
        for (int kb = 0; kb < 4; ++kb) exS[(slice * 4 + kb) * 64 + lane] = pk8(S[2 * kb], S[2 * kb + 1]);
    }
    __syncthreads();
    bf16x8 bE0 = pk8(S[0], S[0]), bE1 = bE0; float gl = 0.f;
    f32x4 QS[4];
#pragma unroll
    for (int rt = 0; rt < 4; ++rt) QS[rt] = (f32x4){0.f, 0.f, 0.f, 0.f};
#pragma unroll 1
    for (int n = 0; n < 128; ++n) {
        if (n + 1 < 128) { GDN_LOAD(n + 1); }
        if (wid < 2) {
            bf16x8 bS[4];
#pragma unroll
            for (int kb = 0; kb < 4; ++kb) bS[kb] = pk8(S[2 * kb], S[2 * kb + 1]);
            f32x4 KS[4];
#pragma unroll
            for (int rt = 0; rt < 4; ++rt) {
                f32x4 a = (f32x4){0.f, 0.f, 0.f, 0.f};
#pragma unroll
                for (int kb = 0; kb < 4; ++kb) a = mfma16(ldperm(Kc + (16 * rt + fr) * 136 + 32 * kb + 4 * fq), bS[kb], a);
                KS[rt] = a;
            }
            gl = egS[63];
            f32x4 R[4];
#pragma unroll
            for (int rt = 0; rt < 4; ++rt)
#pragma unroll
                for (int jj = 0; jj < 4; ++jj) {
                    const int i = 16 * rt + 4 * fq + jj;
                    R[rt][jj] = betaS[i] * (bf2f(Vs[i * 40 + slice * 16 + fr]) - egS[i] * KS[rt][jj]);
                }
            const bf16x8 bR0 = pk8(R[0], R[1]), bR1 = pk8(R[2], R[3]);
            f32x4 D[4];
#pragma unroll
            for (int rt = 0; rt < 4; ++rt) {
                f32x4 a = (f32x4){0.f, 0.f, 0.f, 0.f};
                a = mfma16(ldperm(Tm + (16 * rt + fr) * 72 + 4 * fq), bR0, a);
                a = mfma16(ldperm(Tm + (16 * rt + fr) * 72 + 32 + 4 * fq), bR1, a);
                D[rt] = a;
            }
            exD[(slice * 2 + 0) * 64 + lane] = pk8(D[0], D[1]); exD[(slice * 2 + 1) * 64 + lane] = pk8(D[2], D[3]);
#pragma unroll
            for (int rt = 0; rt < 4; ++rt)
#pragma unroll
                for (int jj = 0; jj < 4; ++jj) D[rt][jj] *= edS[16 * rt + 4 * fq + jj];
            bE0 = pk8(D[0], D[1]); bE1 = pk8(D[2], D[3]);
        } else if (wid < 4) {
            bf16x8 bS[4];
#pragma unroll
            for (int kb = 0; kb < 4; ++kb) bS[kb] = exS[(slice * 4 + kb) * 64 + lane];
#pragma unroll
            for (int rt = 0; rt < 4; ++rt) {
                f32x4 a = (f32x4){0.f, 0.f, 0.f, 0.f};
#pragma unroll
                for (int kb = 0; kb < 4; ++kb) a = mfma16(ldperm(Qc + (16 * rt + fr) * 136 + 32 * kb + 4 * fq), bS[kb], a);
                QS[rt] = a;
            }
        }
        __syncthreads();
        if (wid < 2) {
            const float egl = gl;
#pragma unroll
            for (int t = 0; t < 8; ++t) {
                f32x4 a = S[t] * egl;
                a = mfma16(ldperm(KT + (16 * t + fr) * 72 + 4 * fq), bE0, a);
                a = mfma16(ldperm(KT + (16 * t + fr) * 72 + 32 + 4 * fq), bE1, a);
                S[t] = a;
            }
#pragma unroll
            for (int kb = 0; kb < 4; ++kb) exS[(slice * 4 + kb) * 64 + lane] = pk8(S[2 * kb], S[2 * kb + 1]);
        } else if (wid < 4) {
            const bf16x8 bD0 = exD[(slice * 2 + 0) * 64 + lane], bD1 = exD[(slice * 2 + 1) * 64 + lane];
#pragma unroll
            for (int rt = 0; rt < 4; ++rt) {
                f32x4 a = (f32x4){0.f, 0.f, 0.f, 0.f};
                a = mfma16(ldperm(QK + (16 * rt + fr) * 72 + 4 * fq), bD0, a);
                a = mfma16(ldperm(QK + (16 * rt + fr) * 72 + 32 + 4 * fq), bD1, a);
#pragma unroll
                for (int jj = 0; jj < 4; ++jj) {
                    const int i = 16 * rt + 4 * fq + jj;
                    const float o = egS[i] * QS[rt][jj] + a[jj];
                    mo[(tok0 + n * 64 + i) * DM + h * 128 + dv] = f2bf(o);
                }
            }
        }
        __syncthreads();
        if (n + 1 < 128) GDN_STORE();
        __syncthreads();
    }
#undef GDN_LOAD
#undef GDN_STORE
}

DEV void swa_item(const Params& p, int item) {
    bf16_t* P = (bf16_t*)(p.ws + OFF_P); float* lseG = (float*)(p.ws + OFF_LSE); const float* blut = (const float*)(p.ws + OFF_BLUT);
    bf16_t* Qs = (bf16_t*)g_shm; bf16_t* Ks = Qs + 128 * 72; bf16_t* Vt = Ks + 256 * 72;
    const int tid = opq_tid(), wid = tid >> 6, lane = tid & 63, fr = lane & 15, fq = lane >> 4;
    const int blk64 = item & 63, h = (item >> 6) & 3, g = (item >> 8) % 3, b = item / 768;
    const int d = (g == 0) ? 1 : (g == 1 ? 4 : 16), nb = 64 / d;
    const int res = blk64 / nb, ib = blk64 % nb;
    const size_t tok0 = (size_t)b * SEQ;
    const int qcol = 3072 + g * 256 + h * 64, kcol = 3840 + g * 256 + h * 64, vcol = 4608 + g * 256 + h * 64;
    __syncthreads();
#pragma unroll
    for (int i = 0; i < 2; ++i) { const int idx = tid + 512 * i, a = idx >> 3, c8 = (idx & 7) * 8;
        *(u32x4*)(Qs + a * 72 + c8) = *(const u32x4*)(P + (tok0 + (size_t)(128 * ib + a) * d + res) * LDE + qcol + c8); }
#pragma unroll
    for (int i = 0; i < 4; ++i) { const int idx = tid + 512 * i, kj = idx & 255, c8 = (idx >> 8) * 8; const int sk = 128 * (ib - 1) + kj;
        u32x4 kv = (u32x4){0u, 0u, 0u, 0u}, vv = (u32x4){0u, 0u, 0u, 0u};
        if (sk >= 0) { const size_t tok = tok0 + (size_t)sk * d + res; kv = *(const u32x4*)(P + tok * LDE + kcol + c8); vv = *(const u32x4*)(P + tok * LDE + vcol + c8); }
        *(u32x4*)(Ks + kj * 72 + c8) = kv;
#pragma unroll
        for (int e = 0; e < 4; ++e) { Vt[(c8 + 2 * e) * 264 + kj] = (bf16_t)(vv[e] & 0xffffu); Vt[(c8 + 2 * e + 1) * 264 + kj] = (bf16_t)(vv[e] >> 16); } }
    __syncthreads();
    {
        const int a0 = 16 * wid;
        const bf16x8 bq0 = ld8(Qs + (a0 + fr) * 72 + fq * 8), bq1 = ld8(Qs + (a0 + fr) * 72 + 32 + fq * 8);
        f32x4 s[10];
        float mx = -INFINITY;
        const float* bl = blut + h * NLUT;
#pragma unroll
        for (int kt = 0; kt < 9; ++kt) {
            f32x4 acc = (f32x4){0.f, 0.f, 0.f, 0.f};
            acc = mfma16(ld8(Ks + (a0 + 16 * kt + fr) * 72 + fq * 8), bq0, acc);
            acc = mfma16(ld8(Ks + (a0 + 16 * kt + fr) * 72 + 32 + fq * 8), bq1, acc);
#pragma unroll
            for (int jj = 0; jj < 4; ++jj) {
                const int rel = fr + 128 - 16 * kt - 4 * fq - jj; const int kj = a0 + 16 * kt + 4 * fq + jj;
                const bool ok = (rel >= 0) && (rel <= 128) && (ib > 0 || kj >= 128);
                const int di = min(max(rel, 0) * d, NLUT - 1);
                const float sc = ok ? (acc[jj] * 0.125f + bl[di]) : -INFINITY;
                s[kt][jj] = sc; mx = fmaxf(mx, sc);
            }
        }
        s[9] = (f32x4){-INFINITY, -INFINITY, -INFINITY, -INFINITY};
        mx = fmaxf(mx, __shfl_xor(mx, 16)); mx = fmaxf(mx, __shfl_xor(mx, 32));
        float l = 0.f;
#pragma unroll
        for (int kt = 0; kt < 10; ++kt)
#pragma unroll
            for (int jj = 0; jj < 4; ++jj) { const float pe = __expf(s[kt][jj] - mx); s[kt][jj] = pe; l += pe; }
        l += __shfl_xor(l, 16); l += __shfl_xor(l, 32);
        f32x4 O[4];
#pragma unroll
        for (int dt = 0; dt < 4; ++dt) O[dt] = (f32x4){0.f, 0.f, 0.f, 0.f};
#pragma unroll
        for (int ks = 0; ks < 5; ++ks) {
            const bf16x8 bp = pk8(s[2 * ks], s[2 * ks + 1]);
#pragma unroll
            for (int dt = 0; dt < 4; ++dt) {
                const bf16_t* vp = Vt + (16 * dt + fr) * 264 + a0 + 32 * ks + 4 * fq;
                const u32x2 lo = *(const u32x2*)vp; u32x2 hi = (u32x2){0u, 0u};
                if (ks < 4) hi = *(const u32x2*)(vp + 16);
                O[dt] = mfma16(mk8(lo.x, lo.y, hi.x, hi.y), bp, O[dt]);
            }
        }
        const float inv = 1.0f / l;
        const size_t tok = tok0 + (size_t)(128 * ib + a0 + fr) * d + res;
#pragma unroll
        for (int dt = 0; dt < 4; ++dt) { u32x2 w; w.x = pk2(O[dt][0] * inv, O[dt][1] * inv); w.y = pk2(O[dt][2] * inv, O[dt][3] * inv);
            *(u32x2*)(P + tok * LDE + qcol + 16 * dt + 4 * fq) = w; }
        if (fq == 0) lseG[tok * 12 + g * 4 + h] = mx + __logf(l);
    }
}

DEV void even_post(const Params& p) {
    const bf16_t* P = (const bf16_t*)(p.ws + OFF_P); const float* lseG = (const float*)(p.ws + OFF_LSE); bf16_t* mo = (bf16_t*)(p.ws + OFF_HB);
    const int tid = opq_tid(), wid = tid >> 6, lane = tid & 63;
    const float nw0 = p.gdn_norm_w[2 * lane], nw1 = p.gdn_norm_w[2 * lane + 1];
    const int hh = lane >> 4, d4 = (lane & 15) * 4;
    const int stride = (int)gridDim.x * 8;
#pragma unroll 1
    for (int tok0 = blockIdx.x * 8 + wid; tok0 < MTOK; tok0 += 2 * stride) {
        unsigned raw[2][6], z[2][6]; float ls[2][3]; u32x2 og[2][3];
#pragma unroll
        for (int u = 0; u < 2; ++u) {
            const int tok = min(tok0 + u * stride, MTOK - 1);
#pragma unroll
            for (int h = 0; h < 6; ++h) { raw[u][h] = *(const unsigned*)(mo + (size_t)tok * DM + h * 128 + 2 * lane); z[u][h] = *(const unsigned*)(P + (size_t)tok * LDE + 2304 + h * 128 + 2 * lane); }
#pragma unroll
            for (int g = 0; g < 3; ++g) { ls[u][g] = lseG[(size_t)tok * 12 + g * 4 + hh]; og[u][g] = *(const u32x2*)(P + (size_t)tok * LDE + 3072 + g * 256 + hh * 64 + d4); }
        }
#pragma unroll
        for (int u = 0; u < 2; ++u) {
            const int tok = tok0 + u * stride;
            if (tok < MTOK) {
#pragma unroll
                for (int h = 0; h < 6; ++h) {
                    const float a = lo2f(raw[u][h]), c = hi2f(raw[u][h]);
                    const float rstd = rsqrtf(wsum(a * a + c * c) * (1.0f / 128.0f) + 1e-6f);
                    *(unsigned*)(mo + (size_t)tok * DM + h * 128 + 2 * lane) = pk2(a * rstd * nw0 * silu(lo2f(z[u][h])), c * rstd * nw1 * silu(hi2f(z[u][h])));
                }
                const float l0 = ls[u][0], l1 = ls[u][1], l2 = ls[u][2];
                const float m = fmaxf(l0, fmaxf(l1, l2)); float w0 = __expf(l0 - m), w1 = __expf(l1 - m), w2 = __expf(l2 - m); const float iv = 1.0f / (w0 + w1 + w2); w0 *= iv; w1 *= iv; w2 *= iv;
                const u32x2 o0 = og[u][0], o1 = og[u][1], o2 = og[u][2];
                u32x2 w;
                w.x = pk2(w0 * lo2f(o0.x) + w1 * lo2f(o1.x) + w2 * lo2f(o2.x), w0 * hi2f(o0.x) + w1 * hi2f(o1.x) + w2 * hi2f(o2.x));
                w.y = pk2(w0 * lo2f(o0.y) + w1 * lo2f(o1.y) + w2 * lo2f(o2.y), w0 * hi2f(o0.y) + w1 * hi2f(o1.y) + w2 * hi2f(o2.y));
                *(u32x2*)(mo + (size_t)tok * DM + 768 + hh * 64 + d4) = w;
            }
        }
    }
}

template <int MODE> DEV void diff_scores(const bf16_t* K_, const float* bl, const bf16x8 (&bq)[2][2], int qrow, int k0, int fr, int fq, float SC,
                                         float (&m)[2], float (&l)[2], f32x4 (&O)[2][8], bf16x8 (&bp)[2][2]) {
    const float bfar = bl[NLUT - 1];
#pragma unroll
    for (int c = 0; c < 2; ++c) {
        f32x4 s[4];
        const bf16x8 bq0 = bq[c][0], bq1 = bq[c][1];
#pragma unroll
        for (int k4 = 0; k4 < 4; ++k4) {
            f32x4 acc = (f32x4){0.f, 0.f, 0.f, 0.f};
            acc = mfma16(ld8(K_ + (16 * k4 + fr) * 136 + c * 64 + fq * 8), bq0, acc);
            acc = mfma16(ld8(K_ + (16 * k4 + fr) * 136 + c * 64 + 32 + fq * 8), bq1, acc);
            s[k4] = acc;
            asm volatile("" ::: "memory");
        }
        float mt = -INFINITY;
#pragma unroll
        for (int k4 = 0; k4 < 4; ++k4)
#pragma unroll
            for (int jj = 0; jj < 4; ++jj) {
                const int dist = qrow - (k0 + 16 * k4 + 4 * fq + jj);
                float sc;
                if (MODE == 0) sc = s[k4][jj] * SC + bfar;
                else if (MODE == 1) sc = s[k4][jj] * SC + bl[min(dist, NLUT - 1)];
                else { sc = s[k4][jj] * SC + bl[min(max(dist, 0), NLUT - 1)]; if (dist < 0) sc = -INFINITY; }
                s[k4][jj] = sc; mt = fmaxf(mt, sc);
                if (MODE != 0 && jj == 3) asm volatile("" ::: "memory");
            }
        mt = fmaxf(mt, __shfl_xor(mt, 16)); mt = fmaxf(mt, __shfl_xor(mt, 32));
        const float mn = fmaxf(m[c], mt); const float al = ex2(m[c] - mn); m[c] = mn;
        float ls = 0.f;
#pragma unroll
        for (int k4 = 0; k4 < 4; ++k4)
#pragma unroll
            for (int jj = 0; jj < 4; ++jj) { const float pe = ex2(s[k4][jj] - mn); s[k4][jj] = pe; ls += pe; }
        l[c] = l[c] * al + ls;
        bp[c][0] = pk8(s[0], s[1]); bp[c][1] = pk8(s[2], s[3]);
        if (__ballot(al < 1.0f) != 0ull) {
#pragma unroll
            for (int dt = 0; dt < 8; ++dt) O[c][dt] *= al;
        }
        asm volatile("" ::: "memory");
    }
}

DEV void diff_item(const Params& p, int item) {
    const bf16_t* P = (const bf16_t*)(p.ws + OFF_P); bf16_t* mo = (bf16_t*)(p.ws + OFF_HB);
    bf16_t* Ks = (bf16_t*)g_shm;
    bf16_t* Vt = Ks + 2 * 64 * 136;
    float* bl = (float*)(Vt + 2 * 128 * 72);
    bf16_t* Qs = (bf16_t*)(bl + NLUT);
    const int tid = opq_tid(), wid = __builtin_amdgcn_readfirstlane(tid >> 6), lane = tid & 63, fr = lane & 15, fq = lane >> 4;
    const int qb = 63 - (item >> 4), bh = item & 15, b = bh >> 2, h = bh & 3;
    const size_t tok0 = (size_t)b * SEQ;
    const int q0 = qb * 128, qw0 = q0 + 16 * wid, qrow = qw0 + fr;
    const int nkt = 2 * (qb + 1);
    __syncthreads();
    { const float* blg = (const float*)(p.ws + OFF_BLUT) + h * NLUT; for (int i = tid; i < NLUT; i += 512) bl[i] = blg[i] * LOG2E; }
    bf16x8 bq[2][2];
#pragma unroll
    for (int c = 0; c < 2; ++c)
#pragma unroll
        for (int kb = 0; kb < 2; ++kb) bq[c][kb] = *(const bf16x8*)(P + (tok0 + qrow) * LDO + h * 128 + c * 64 + kb * 32 + fq * 8);
    u32x4 rk[2], rv[2];
#define DF_LOADK(kt_) do { _Pragma("unroll") for (int i = 0; i < 2; ++i) { const int idx = tid + 512 * i, r = idx >> 4, c8 = (idx & 15) * 8; \
        rk[i] = *(const u32x4*)(P + (tok0 + (size_t)(kt_) * 64 + r) * LDO + 512 + h * 128 + c8); } } while (0)
#define DF_LOADV(kt_) do { _Pragma("unroll") for (int i = 0; i < 2; ++i) { const int idx = tid + 512 * i; \
        rv[i] = *(const u32x4*)(P + (tok0 + (size_t)(kt_) * 64 + (idx >> 4)) * LDO + 1024 + h * 128 + (idx & 15) * 8); } } while (0)
#define DF_LOAD(kt_) do { DF_LOADK(kt_); DF_LOADV(kt_); } while (0)
#define DF_STORE(buf_) do { bf16_t* K_ = Ks + (buf_) * 64 * 136; bf16_t* V_ = Vt + (buf_) * 128 * 72; \
        _Pragma("unroll") for (int i = 0; i < 2; ++i) { const int idx = tid + 512 * i, r = idx >> 4, c8 = (idx & 15) * 8; *(u32x4*)(K_ + r * 136 + c8) = rk[i]; \
            { const int vr_ = (idx >> 4) ^ ((idx & 15) * 4), vc_ = (idx & 15) * 8; _Pragma("unroll") for (int e = 0; e < 4; ++e) { V_[(vc_ + 2 * e) * 72 + vr_] = (bf16_t)(rv[i][e] & 0xffffu); V_[(vc_ + 2 * e + 1) * 72 + vr_] = (bf16_t)(rv[i][e] >> 16); } } } } while (0)
    DF_LOAD(0); DF_STORE(0);
    __syncthreads();
    f32x4 O[2][8]; float m[2] = {-INFINITY, -INFINITY}, l[2] = {0.f, 0.f};
#pragma unroll
    for (int c = 0; c < 2; ++c)
#pragma unroll
        for (int dt = 0; dt < 8; ++dt) O[c][dt] = (f32x4){0.f, 0.f, 0.f, 0.f};
    const float SC = 0.125f * LOG2E;
#pragma unroll 1
    for (int kt = 0; kt < nkt; ++kt) {
        const int buf = kt & 1, k0 = kt * 64;
        if (kt + 1 < nkt) DF_LOAD(kt + 1);
        if (k0 <= qw0 + 15) {
            const bf16_t* K_ = Ks + buf * 64 * 136; const bf16_t* V_ = Vt + buf * 128 * 72;
            const bool need_mask = (k0 + 63 > qw0);
            const bool far = (qw0 - (k0 + 63) >= NLUT - 1);
            bf16x8 bp[2][2];
            if (far) diff_scores<0>(K_, bl, bq, qrow, k0, fr, fq, SC, m, l, O, bp);
            else if (!need_mask) diff_scores<1>(K_, bl, bq, qrow, k0, fr, fq, SC, m, l, O, bp);
            else diff_scores<2>(K_, bl, bq, qrow, k0, fr, fq, SC, m, l, O, bp);
            int frv = fr; asm volatile("" : "+v"(frv));
            const int fr8x4 = 4 * (frv >> 3), fq4 = 4 * (frv == fr ? fq : 0);
#pragma unroll
            for (int ks = 0; ks < 2; ++ks)
#pragma unroll
                for (int dt = 0; dt < 8; ++dt) {
                    const int vsw = 8 * dt + fr8x4;
                    const u32x2 alo = *(const u32x2*)(V_ + (16 * dt + frv) * 72 + ((32 * ks + fq4) ^ vsw)), ahi = *(const u32x2*)(V_ + (16 * dt + frv) * 72 + ((32 * ks + 16 + fq4) ^ vsw));
                    const bf16x8 a = mk8(alo.x, alo.y, ahi.x, ahi.y);
                    O[0][dt] = mfma16(a, bp[0][ks], O[0][dt]); O[1][dt] = mfma16(a, bp[1][ks], O[1][dt]);

                }
        }
        if (kt + 1 < nkt) DF_STORE(buf ^ 1);
        __syncthreads();
    }
#undef DF_LOAD
#undef DF_LOADK
#undef DF_LOADV
#undef DF_STORE
    {
        float l0 = l[0], l1 = l[1];
        l0 += __shfl_xor(l0, 16); l0 += __shfl_xor(l0, 32); l1 += __shfl_xor(l1, 16); l1 += __shfl_xor(l1, 32);
        const float lam = *(const float*)(p.ws + OFF_LAM);
        const float i0 = 1.0f / l0, i1 = lam / l1;
        float ss = 0.f;
#pragma unroll
        for (int dt = 0; dt < 8; ++dt) { O[0][dt] = O[0][dt] * i0 - O[1][dt] * i1; ss += (O[0][dt][0] * O[0][dt][0] + O[0][dt][1] * O[0][dt][1]) + (O[0][dt][2] * O[0][dt][2] + O[0][dt][3] * O[0][dt][3]); }
        ss += __shfl_xor(ss, 16); ss += __shfl_xor(ss, 32);
        const float rs = rsqrtf(ss * (1.0f / 128.0f) + 1e-6f) * (1.0f - LAM_INIT);
#pragma unroll
        for (int dt = 0; dt < 8; ++dt) {
            const f32x4 nw = *(const f32x4*)(p.diff_norm_w + 16 * dt + 4 * fq);
            u32x2 w; w.x = pk2(O[0][dt][0] * rs * nw[0], O[0][dt][1] * rs * nw[1]); w.y = pk2(O[0][dt][2] * rs * nw[2], O[0][dt][3] * rs * nw[3]);
            *(u32x2*)(mo + (tok0 + qrow) * DM + h * 128 + 16 * dt + 4 * fq) = w;
        }
    }
}

DEV void gla_task(const Params& p, int task) {
    const bf16_t* P = (const bf16_t*)(p.ws + OFF_P); bf16_t* mo = (bf16_t*)(p.ws + OFF_HB); const float* thin = (const float*)(p.ws + OFF_THIN);
    bf16_t* qt = (bf16_t*)g_shm; bf16_t* kt = qt + 64 * 72; bf16_t* khT = kt + 64 * 72; bf16_t* vT = khT + 64 * 72; bf16_t* at = vT + 128 * 72;
    float* bL = (float*)(at + 64 * 72); float* el = bL + 64 * 65; float* ssq = el + 64;
    float* thL = ssq + 512; bf16_t* rL = (bf16_t*)(thL + 1024);
    const int tid = opq_tid(), wid = tid >> 6, lane = tid & 63, fr = lane & 15, fq = lane >> 4;
    const int b = task >> 2, h = task & 3; const size_t tok0 = (size_t)b * SEQ;
    const int kch = tid & 63;
    float wg[16];
#pragma unroll
    for (int j = 0; j < 16; ++j) wg[j] = p.gla_w_gate[j * 256 + h * 64 + kch];
    const float bgate = p.gla_b_gate[h * 64 + kch];
    const int dv = 16 * wid + fr;
    f32x4 S[4];
#pragma unroll
    for (int t = 0; t < 4; ++t) S[t] = (f32x4){0.f, 0.f, 0.f, 0.f};
    u32x4 pq, pk_, pv[2]; f32x4 pth = (f32x4){0.f, 0.f, 0.f, 0.f};
#define GLA_LOAD(n_) do { const size_t tn_ = tok0 + (size_t)(n_) * 64; \
        pq = *(const u32x4*)(P + (tn_ + (tid & 63)) * LDO + 1536 + h * 64 + (tid >> 6) * 8); pk_ = *(const u32x4*)(P + (tn_ + (tid & 63)) * LDO + 1792 + h * 64 + (tid >> 6) * 8); \
        _Pragma("unroll") for (int i = 0; i < 2; ++i) { const int idx = tid + 512 * i; pv[i] = *(const u32x4*)(P + (tn_ + (idx & 63)) * LDO + 2048 + h * 128 + (idx >> 6) * 8); \
            } \
        if (tid < 256) pth = *(const f32x4*)(thin + (tn_ + (tid >> 2)) * 16 + (tid & 3) * 4); } while (0)
#define GLA_STORE_TR() do { if (tid < 256) *(f32x4*)(thL + (tid >> 2) * 16 + (tid & 3) * 4) = pth; } while (0)
    __syncthreads();
    GLA_LOAD(0); GLA_STORE_TR();
    __syncthreads();
#pragma unroll 1
    for (int n = 0; n < 128; ++n) {
        const size_t t0 = tok0 + (size_t)n * 64;
#pragma unroll
        for (int it = 0; it < 8; ++it) {
            const int r = (tid >> 6) + 8 * it; const float* gd = thL + r * 16;
            float x = bgate;
#pragma unroll
            for (int j = 0; j < 16; ++j) x += gd[j] * wg[j];
            const float ls = (x < -15.f) ? x : -__logf(1.0f + __expf(-x));
            bL[r * 65 + kch] = ls * (1.0f / 16.0f);
        }
        __syncthreads();
        {
            const int part = tid >> 6; float loc[8]; float run = 0.f;
#pragma unroll
            for (int q = 0; q < 8; ++q) { run += bL[(part * 8 + q) * 65 + kch]; loc[q] = run; }
            ssq[part * 64 + kch] = run;
            __syncthreads();
            float off = 0.f;
#pragma unroll
            for (int q = 0; q < 7; ++q) off += (q < part) ? ssq[q * 64 + kch] : 0.f;
#pragma unroll
            for (int q = 0; q < 8; ++q) bL[(part * 8 + q) * 65 + kch] = loc[q] + off;
            if (part == 7) el[kch] = __expf(loc[7] + off);
        }
        __syncthreads();
        {
            const int r = tid & 63, c8 = (tid >> 6) * 8;
            const u32x4 qr = pq, kr = pk_;
            float qf[8], kf[8], kh[8];
#pragma unroll
            for (int e = 0; e < 4; ++e) { qf[2 * e] = lo2f(qr[e]); qf[2 * e + 1] = hi2f(qr[e]); kf[2 * e] = lo2f(kr[e]); kf[2 * e + 1] = hi2f(kr[e]); }
#pragma unroll
            for (int e = 0; e < 8; ++e) { const float bb = bL[r * 65 + c8 + e], blast = bL[63 * 65 + c8 + e];
                qf[e] *= 0.125f * __expf(bb); kh[e] = kf[e] * __expf(blast - bb); kf[e] *= __expf(fminf(-bb, 80.f)); }
            u32x4 w; w.x = pk2(qf[0], qf[1]); w.y = pk2(qf[2], qf[3]); w.z = pk2(qf[4], qf[5]); w.w = pk2(qf[6], qf[7]); *(u32x4*)(qt + r * 72 + c8) = w;
            w.x = pk2(kf[0], kf[1]); w.y = pk2(kf[2], kf[3]); w.z = pk2(kf[4], kf[5]); w.w = pk2(kf[6], kf[7]); *(u32x4*)(kt + r * 72 + c8) = w;
#pragma unroll
            for (int e = 0; e < 8; ++e) khT[(c8 + e) * 72 + r] = f2bf(kh[e]);
#pragma unroll
            for (int i = 0; i < 2; ++i) { const int idx = tid + 512 * i, rr = idx & 63, v8 = (idx >> 6) * 8; const u32x4 vr = pv[i];
#pragma unroll
                for (int e = 0; e < 4; ++e) { vT[(v8 + 2 * e) * 72 + rr] = (bf16_t)(vr[e] & 0xffffu); vT[(v8 + 2 * e + 1) * 72 + rr] = (bf16_t)(vr[e] >> 16); } }
        }
        if (n + 1 < 128) GLA_LOAD(n + 1);
        __syncthreads();
#pragma unroll
        for (int tt = 0; tt < 2; ++tt) {
            const int tile = 2 * wid + tt, itile = tile >> 2, jt = tile & 3;
            f32x4 acc = (f32x4){0.f, 0.f, 0.f, 0.f};
            if (jt <= itile) {
#pragma unroll
                for (int kb = 0; kb < 2; ++kb) acc = mfma16(ld8(qt + (16 * itile + fr) * 72 + kb * 32 + fq * 8), ld8(kt + (16 * jt + fr) * 72 + kb * 32 + fq * 8), acc);
            }
#pragma unroll
            for (int jj = 0; jj < 4; ++jj) { const int i = 16 * itile + 4 * fq + jj, j = 16 * jt + fr; at[i * 72 + j] = (i >= j) ? f2bf(acc[jj]) : (bf16_t)0; }
        }
        __syncthreads();
        f32x4 o[4];
        {
            const bf16x8 bS0 = pk8(S[0], S[1]), bS1 = pk8(S[2], S[3]);
            const bf16x8 bv0 = ld8(vT + dv * 72 + fq * 8), bv1 = ld8(vT + dv * 72 + 32 + fq * 8);
#pragma unroll
            for (int rt = 0; rt < 4; ++rt) {
                f32x4 a = (f32x4){0.f, 0.f, 0.f, 0.f};
                a = mfma16(ldperm(qt + (16 * rt + fr) * 72 + 4 * fq), bS0, a);
                a = mfma16(ldperm(qt + (16 * rt + fr) * 72 + 32 + 4 * fq), bS1, a);
                a = mfma16(ld8(at + (16 * rt + fr) * 72 + fq * 8), bv0, a);
                a = mfma16(ld8(at + (16 * rt + fr) * 72 + 32 + fq * 8), bv1, a);
                o[rt] = a;
            }
#pragma unroll
            for (int t = 0; t < 4; ++t) {
                f32x4 a;
#pragma unroll
                for (int jj = 0; jj < 4; ++jj) a[jj] = S[t][jj] * el[16 * t + 4 * fq + jj];
                a = mfma16(ld8(khT + (16 * t + fr) * 72 + fq * 8), bv0, a);
                a = mfma16(ld8(khT + (16 * t + fr) * 72 + 32 + fq * 8), bv1, a);
                S[t] = a;
            }
#pragma unroll
            for (int rt = 0; rt < 4; ++rt)
#pragma unroll
                for (int jj = 0; jj < 4; ++jj) mo[(t0 + 16 * rt + 4 * fq + jj) * DM + 512 + h * 128 + dv] = f2bf(o[rt][jj]);
        }
        if (n + 1 < 128) GLA_STORE_TR();
        __syncthreads();
    }
#undef GLA_LOAD
#undef GLA_STORE_TR
}

DEV void odd_post(const Params& p) {
    const bf16_t* P = (const bf16_t*)(p.ws + OFF_P); bf16_t* mo = (bf16_t*)(p.ws + OFF_HB);
    const int tid = opq_tid(), wid = tid >> 6, lane = tid & 63;
    const float nw0 = p.gla_norm_w[2 * lane], nw1 = p.gla_norm_w[2 * lane + 1];
    const int stride = (int)gridDim.x * 8;
#pragma unroll 1
    for (int tok0 = blockIdx.x * 8 + wid; tok0 < MTOK; tok0 += 2 * stride) {
        unsigned raw[2][4], z[2][4];
#pragma unroll
        for (int u = 0; u < 2; ++u) {
            const int tok = min(tok0 + u * stride, MTOK - 1);
#pragma unroll
            for (int h = 0; h < 4; ++h) { raw[u][h] = *(const unsigned*)(mo + (size_t)tok * DM + 512 + h * 128 + 2 * lane); z[u][h] = *(const unsigned*)(P + (size_t)tok * LDO + 2560 + h * 128 + 2 * lane); }
        }
#pragma unroll
        for (int u = 0; u < 2; ++u) {
            const int tok = tok0 + u * stride;
            if (tok < MTOK) {
#pragma unroll
                for (int h = 0; h < 4; ++h) {
                    const float a = lo2f(raw[u][h]), c = hi2f(raw[u][h]);
                    const float rstd = __builtin_amdgcn_rsqf(wsum(a * a + c * c) * (1.0f / 128.0f) + 1e-6f);
                    *(unsigned*)(mo + (size_t)tok * DM + 512 + h * 128 + 2 * lane) = pk2(a * rstd * nw0 * silu(lo2f(z[u][h])), c * rstd * nw1 * silu(hi2f(z[u][h])));
                }
            }
        }
    }
}

#ifndef PH_LO
#define PH_LO 0
#define PH_HI 99
#endif
#define PHASE(k) if ((k) >= PH_LO && (k) <= PH_HI)
#ifdef MULTI_LAUNCH
#define GSYNC()
#define GSYNC_CG()
#else
#define GSYNC() xcd_barrier(xb)
#define GSYNC_CG() grid.sync()
#endif

template <int LO, int HI> __global__ void __launch_bounds__(512, 2) mega(Params kp) {
#ifndef MULTI_LAUNCH
    cg::grid_group grid = cg::this_grid();
    volatile XB_LAS unsigned* xst = (volatile XB_LAS unsigned*)(g_shm + 131072);
    if (threadIdx.x == 0) { xst[0] = 0u; xst[1] = 0u; }
    __syncthreads();
    const XcdBarrier xb = xcd_barrier_post((unsigned*)(kp.ws + OFF_BAR), xst);
#endif
    unsigned char* const wsb = kp.ws;
#define P ((bf16_t*)(wsb + OFF_P))
#define HB ((bf16_t*)(wsb + OFF_HB))
#define WT ((bf16_t*)(wsb + OFF_WT))
#define thin ((float*)(wsb + OFF_THIN))
#define STEP(k) if ((k) >= LO && (k) <= HI)
#ifndef REPK
#define REPK -1
#endif
#define NREP(k) (((k) == REPK) ? 2 : 1)
    STEP(0) { const Params& p = kp; phase_weights(p); rowpass(p.x, nullptr, nullptr, HB, nullptr, nullptr, p.w_in_even + 3072, 5388, 12, thin); }
    if (0 >= LO && 0 < HI) { if (wsb == nullptr) GSYNC_CG(); GSYNC(); }
    STEP(1) for (int rep = 0; rep < NREP(1); ++rep) { const Params p = load_params(wsb); if (rep) GSYNC(); EpiStoreBf16 E; E.O = P; E.ldc = LDE; E.halo = (bf16_t*)(p.ws + OFF_HALO1); E.seg = 64; E.hrows = 3; E.hcols = 2304; run_gemm(HB, DM, WT + W_INE, MTOK, LDE, DM, E); }
    if (1 >= LO && 1 < HI) GSYNC();
    STEP(2) { const Params p = load_params(wsb); gdn_prep(p); }
    if (2 >= LO && 2 < HI) GSYNC();
    STEP(3) { const Params p = load_params(wsb);
        for (int task = blockIdx.x; task < 96; task += gridDim.x) gdn_scan(p, task);
        const int nsw = (int)gridDim.x > 96 ? (int)gridDim.x - 96 : (int)gridDim.x; const int first = (int)gridDim.x > 96 ? (int)blockIdx.x - 96 : (int)blockIdx.x;
        if (first >= 0) for (int item = first; item < 3072; item += nsw) swa_item(p, item);
        {
            unsigned* cnt2 = (unsigned*)(p.ws + OFF_CNT) + 32; int* s_item_p = (int*)(g_shm + 131056);
            for (;;) {
                __syncthreads();
                if (threadIdx.x == 0) *s_item_p = (int)atomicAdd(cnt2, 1u);
                __syncthreads();
                const int t = *s_item_p + 1600;
                if (t >= 6848) break;
                cvt_weight_tile(p, t);
            }
        }
    }
    if (3 >= LO && 3 < HI) GSYNC();
    STEP(4) { const Params p = load_params(wsb); even_post(p); }
    if (4 >= LO && 4 < HI) GSYNC();
    STEP(5) for (int rep = 0; rep < NREP(5); ++rep) { const Params p = load_params(wsb); if (rep) GSYNC(); EpiStoreBf16 E; E.O = P + 2816; E.ldc = LDF; E.halo = nullptr; E.seg = 64; E.hrows = 0; E.hcols = 0; run_gemm(HB, DM, WT + W_OUTE, MTOK, DM, DM, E); }
    if (5 >= LO && 5 < HI) GSYNC();
    STEP(6) { const Params p = load_params(wsb); rowpass(p.x, P + 2816, p.out, HB, p.ln_g, p.ln_b, nullptr, 0, 0, nullptr); }
    if (6 >= LO && 6 < HI) GSYNC();
    STEP(7) for (int rep = 0; rep < NREP(7); ++rep) { const Params p = load_params(wsb); if (rep) GSYNC(); EpiStoreBf16 E; E.O = P; E.ldc = LDF; E.halo = (bf16_t*)(p.ws + OFF_HALO2); E.seg = 128; E.hrows = 2; E.hcols = 5632; run_gemm(HB, DM, WT + W_UP0, MTOK, LDF, DM, E); }
    if (7 >= LO && 7 < HI) GSYNC();
    STEP(8) { const Params p = load_params(wsb); convgate(p, 0); }
    if (8 >= LO && 8 < HI) GSYNC();
    STEP(9) { const Params p = load_params(wsb); EpiStoreBf16 E; E.O = P + 2816; E.ldc = LDF; E.halo = nullptr; E.seg = 64; E.hrows = 0; E.hcols = 0; run_gemm(P, LDF, WT + W_DN0, MTOK, DM, 2816, E); }
    if (9 >= LO && 9 < HI) GSYNC();
    STEP(10) { const Params p = load_params(wsb); rowpass(p.out, P + 2816, p.out, HB, p.ln_g + 1024, p.ln_b + 1024, p.w_in_odd + 3072, 3088, 16, thin); }
    if (10 >= LO && 10 < HI) GSYNC();
    STEP(11) for (int rep = 0; rep < NREP(11); ++rep) { const Params p = load_params(wsb); if (rep) GSYNC(); EpiStoreBf16 E; E.O = P; E.ldc = LDO; E.halo = nullptr; E.seg = 64; E.hrows = 0; E.hcols = 0; run_gemm(HB, DM, WT + W_INO, MTOK, LDO, DM, E); }
    if (11 >= LO && 11 < HI) GSYNC();
    STEP(12) for (int rep = 0; rep < NREP(12); ++rep) { const Params p = load_params(wsb);
        if (rep) GSYNC();
#ifdef REP_NOGLA
        if (rep == 0)
#endif
        for (int task = blockIdx.x; task < 16; task += gridDim.x) gla_task(p, task);
        unsigned* cnt = (unsigned*)(p.ws + OFF_CNT) + 16 * rep; int* s_item_p = (int*)(g_shm + 131056);
        for (;;) {
            __syncthreads();
            if (threadIdx.x == 0) *s_item_p = (int)atomicAdd(cnt, 1u);
            __syncthreads();
            const int item = *s_item_p;
            if (item >= 1024) break;
            diff_item(p, item);
        }
    }
    if (12 >= LO && 12 <= HI) GSYNC();
    STEP(12) { const Params p = load_params(wsb); odd_post(p); }
    if (12 >= LO && 12 < HI) GSYNC();
    STEP(13) { const Params p = load_params(wsb); EpiStoreBf16 E; E.O = P + 2816; E.ldc = LDF; E.halo = nullptr; E.seg = 64; E.hrows = 0; E.hcols = 0; run_gemm(HB, DM, WT + W_OUTO, MTOK, DM, DM, E); }
    if (13 >= LO && 13 < HI) GSYNC();
    STEP(14) { const Params p = load_params(wsb); rowpass(p.out, P + 2816, p.out, HB, p.ln_g + 2048, p.ln_b + 2048, nullptr, 0, 0, nullptr); }
    if (14 >= LO && 14 < HI) GSYNC();
    STEP(15) for (int rep = 0; rep < NREP(15); ++rep) { const Params p = load_params(wsb); if (rep) GSYNC(); EpiStoreBf16 E; E.O = P; E.ldc = LDF; E.halo = (bf16_t*)(p.ws + OFF_HALO2); E.seg = 128; E.hrows = 2; E.hcols = 5632; run_gemm(HB, DM, WT + W_UP1, MTOK, LDF, DM, E); }
    if (15 >= LO && 15 < HI) GSYNC();
    STEP(16) { const Params p = load_params(wsb); convgate(p, 1); }
    if (16 >= LO && 16 < HI) GSYNC();
    STEP(17) { const Params p = load_params(wsb); EpiStoreBf16 E; E.O = P + 2816; E.ldc = LDF; E.halo = nullptr; E.seg = 64; E.hrows = 0; E.hcols = 0; run_gemm(P, LDF, WT + W_DN1, MTOK, DM, 2816, E); }
    if (17 >= LO && 17 < HI) GSYNC();
    STEP(18) { const Params p = load_params(wsb); rowpass(p.out, P + 2816, p.out, nullptr, p.ln_g + 3072, p.ln_b + 3072, nullptr, 0, 0, nullptr); }
#undef STEP
#undef P
#undef HB
#undef WT
#undef thin
}

#ifdef DUMP_ODD
__global__ void dump_odd(Params p) {
    const bf16_t* P = (const bf16_t*)(p.ws + OFF_P); const float* thin = (const float*)(p.ws + OFF_THIN);
    for (size_t i = (size_t)blockIdx.x * 512 + threadIdx.x; i < (size_t)MTOK * 1024; i += (size_t)gridDim.x * 512) {
        const size_t row = i >> 10; const int c = (int)(i & 1023);
        p.out[i] = c < 16 ? thin[row * 16 + c] : bf2f(P[row * LDO + 1536 + c]);
    }
}
#endif
constexpr size_t kDynLds = 131072 + 64;

extern "C" void kernel_launch(void* const* d_in, const int* in_sizes, int n_in, void* d_out, int out_size, void* d_ws, size_t ws_size, hipStream_t stream) {
    (void)in_sizes; (void)n_in; (void)out_size;
    if (ws_size < WS_NEED) { fprintf(stderr, "workspace too small: %zu < %zu\n", ws_size, (size_t)WS_NEED); return; }
    Params p{};
    const float** f = (const float**)&p;
    for (int i = 0; i < 21; ++i) f[i] = (const float*)d_in[i];
    p.out = (float*)d_out; p.ws = (unsigned char*)d_ws;
#ifdef MULTI_LAUNCH
    static bool attr = false;
#define LAUNCH1(k) do { hipFuncSetAttribute((const void*)mega<k, k>, hipFuncAttributeMaxDynamicSharedMemorySize, (int)kDynLds); \
        hipLaunchKernelGGL((mega<k, k>), dim3(256), dim3(512), kDynLds, stream, p); } while (0)
#ifndef LASTPH
#define LASTPH 18
#endif
#define LAUNCHIF(k) do { if ((k) <= LASTPH) LAUNCH1(k); } while (0)
    LAUNCHIF(0); LAUNCHIF(1); LAUNCHIF(2); LAUNCHIF(3); LAUNCHIF(4); LAUNCHIF(5); LAUNCHIF(6); LAUNCHIF(7); LAUNCHIF(8); LAUNCHIF(9);
    LAUNCHIF(10); LAUNCHIF(11); LAUNCHIF(12); LAUNCHIF(13); LAUNCHIF(14); LAUNCHIF(15); LAUNCHIF(16); LAUNCHIF(17); LAUNCHIF(18);
    (void)attr;
#ifdef DUMP_ODD
    hipLaunchKernelGGL(dump_odd, dim3(1024), dim3(512), 0, stream, p);
#endif
#else
    static int grid_blocks = 0;
    if (!grid_blocks) {
        int dev = 0, cus = 0, per_cu = 0;
        hipGetDevice(&dev);
        hipDeviceGetAttribute(&cus, hipDeviceAttributeMultiprocessorCount, dev);
        hipFuncSetAttribute((const void*)mega<0, 99>, hipFuncAttributeMaxDynamicSharedMemorySize, (int)kDynLds);
        hipOccupancyMaxActiveBlocksPerMultiprocessor(&per_cu, mega<0, 99>, 512, kDynLds);
        if (per_cu < 1) per_cu = 1;
        grid_blocks = cus * per_cu;
        if (grid_blocks > 256) grid_blocks = 256;
    }
    hipMemsetAsync((unsigned char*)d_ws + OFF_BAR, 0, XCD_BAR_WORDS * sizeof(unsigned), stream);
    void* args[] = {&p};
    hipError_t e = hipLaunchCooperativeKernel((void*)mega<0, 99>, dim3(grid_blocks), dim3(512), args, kDynLds, stream);
    if (e != hipSuccess) fprintf(stderr, "cooperative launch failed: %s (grid %d)\n", hipGetErrorString(e), grid_blocks);
#endif
}
```

```cpp
#include <hip/hip_runtime.h>
#include <hip/hip_cooperative_groups.h>
#include <cstdio>
#include <cstdint>
namespace cg = cooperative_groups;

extern __shared__ __attribute__((aligned(16))) unsigned char g_shm[];
#define XB_TMO      128
#define XB_XCNT(j)  (256  + 64 * (j))
#define XB_XSUB(j)  (1280 + 64 * (j))
#define XB_XGEN(j)  (2304 + 64 * (j))
#define XB_TOP      3328
#define XB_TOPGEN   3392
#define XCD_BAR_WORDS 3456
#define XB_SPIN_CAP (1u << 18)
#define XB_LAS __attribute__((address_space(3)))

__device__ __forceinline__ unsigned xb_ld(unsigned* p)              { return __hip_atomic_load(p, __ATOMIC_RELAXED, __HIP_MEMORY_SCOPE_AGENT); }
__device__ __forceinline__ unsigned xb_add(unsigned* p, unsigned v) { return __hip_atomic_fetch_add(p, v, __ATOMIC_RELAXED, __HIP_MEMORY_SCOPE_AGENT); }
__device__ __forceinline__ unsigned xb_xcc_id() { return (unsigned)__builtin_amdgcn_s_getreg((3 << 11) | 20) & 0xFu; }
#define XB_SPIN(cond, bar) do { unsigned _sp = 0; while (cond) { __builtin_amdgcn_s_sleep(1); \
    if ((++_sp & 255u) == 0u) { if (xb_ld(&(bar)[XB_TMO])) break; if (_sp > XB_SPIN_CAP) { atomicAdd(&(bar)[XB_TMO], 1u); break; } } } } while (0)

struct XcdBarrier {
    unsigned* bar; unsigned x;
    volatile XB_LAS unsigned* st;
};

__device__ __forceinline__ XcdBarrier xcd_barrier_post(unsigned* bar, volatile XB_LAS unsigned* st) {
    XcdBarrier b; b.bar = bar; b.x = xb_xcc_id(); b.st = st;
    if (threadIdx.x == 0) (void)xb_add(&bar[XB_XCNT(b.x)], 1u);
    return b;
}
__device__ __forceinline__ void xcd_barrier_complete(unsigned* bar, unsigned x, unsigned& nloc, unsigned& nx) {
    const unsigned G = gridDim.x * gridDim.y * gridDim.z;
    unsigned sum, cnt, mine, sp = 0u;
    for (;;) {
        sum = 0u; cnt = 0u; mine = 0u;
#pragma unroll
        for (unsigned j = 0; j < 16; ++j) { const unsigned c = xb_ld(&bar[XB_XCNT(j)]); sum += c; cnt += (c > 0u) ? 1u : 0u; mine = (j == x) ? c : mine; }
        if (sum == G) break;
        __builtin_amdgcn_s_sleep(1);
        if ((++sp & 255u) == 0u) { if (xb_ld(&bar[XB_TMO])) break; if (sp > XB_SPIN_CAP) { atomicAdd(&bar[XB_TMO], 1u); break; } }
    }
    nloc = mine > 0u ? mine : 1u; nx = cnt > 0u ? cnt : 1u;
}

__device__ __forceinline__ void xcd_barrier(const XcdBarrier& b) {
    asm volatile("s_waitcnt vmcnt(0)" ::: "memory");
    __syncthreads();
    if (threadIdx.x == 0) {
        unsigned* bar = b.bar;
        __builtin_amdgcn_s_waitcnt(0);
        unsigned nloc = b.st[0], nx = b.st[1];
        if (nloc == 0u) { xcd_barrier_complete(bar, b.x, nloc, nx); b.st[0] = nloc; b.st[1] = nx; }
        const unsigned old = xb_add(&bar[XB_XSUB(b.x)], 1u);
        const unsigned gen = old / nloc;
        if (old + 1u == (gen + 1u) * nloc) {
            __builtin_amdgcn_fence(__ATOMIC_RELEASE, "agent");
            asm volatile("s_waitcnt vmcnt(0)" ::: "memory");
            const unsigned og = xb_add(&bar[XB_TOP], 1u);
            const unsigned tg = og / nx;
            if (og + 1u == (tg + 1u) * nx) xb_add(&bar[XB_TOPGEN], 1u);
            else XB_SPIN(xb_ld(&bar[XB_TOPGEN]) == tg, bar);
            __builtin_amdgcn_fence(__ATOMIC_ACQUIRE, "agent");
            xb_add(&bar[XB_XGEN(b.x)], 1u);
            asm volatile("s_waitcnt vmcnt(0)" ::: "memory");
        } else {
            XB_SPIN(xb_ld(&bar[XB_XGEN(b.x)]) == gen, bar);
            __builtin_amdgcn_fence(__ATOMIC_ACQUIRE, "agent");
            asm volatile("s_waitcnt vmcnt(0)" ::: "memory");
        }
    }
    __syncthreads();
}

__device__ __forceinline__ int opq_tid() { int t = threadIdx.x; asm volatile("" : "+v"(t)); return t; }
namespace pg8 {
#define PG8_LAS __attribute__((address_space(3)))
typedef unsigned short bf16_t;
typedef short bf16x8 __attribute__((ext_vector_type(8)));
typedef float f32x4 __attribute__((ext_vector_type(4)));
typedef unsigned u32x4 __attribute__((ext_vector_type(4)));
constexpr int BM = 256, BK = 64, HALF = 128, HTB = HALF * BK * 2  , STAGE_BYTES = 8 * HTB, NXCD = 8, WGM = 8;

__host__ __device__ __forceinline__ int lds_byte(int r, int c) { const int st = (r >> 4) * 2 + (c >> 5), rr = r & 15, cc = c & 31, ob = rr * 64 + cc * 2; return st * 1024 + (ob ^ (((ob >> 9) & 1) << 5)); }
__host__ __device__ __forceinline__ void stage_rc(int b, int& R, int& C) { const int st = b / 1024, sb = b % 1024, swz = sb ^ (((sb >> 9) & 1) << 5); R = (st >> 1) * 16 + swz / 64; C = (st & 1) * 32 + (swz % 64) / 2; }
__host__ __device__ __forceinline__ int perm32(int rho) { const int n = rho >> 4, i = rho & 15; return 8 * (i >> 2) + 4 * n + (i & 3); }
struct Unit { int pm, pn; };
struct Gemm { const bf16_t* A; const bf16_t* Bt; int M, N, K, lda; };

struct StaticOrder {
    int nM, nN, nwg, G, c;
    __host__ __device__ void init(int M, int N, int G_, int c_) { nM = M / BM; nN = N / BM; nwg = nM * nN; G = G_; c = c_; }
    __host__ __device__ bool next(int i, Unit& u) const {
        const long L = (long)i * G + c; if (L >= nwg) return false;
        int wgid = (int)L; { const int q = nwg / NXCD, r = nwg % NXCD, xcd = wgid % NXCD, off = wgid / NXCD; wgid = (xcd < r ? xcd * (q + 1) : r * (q + 1) + (xcd - r) * q) + off; }
        const int nig = WGM * nN, gid = wgid / nig, fm = gid * WGM, gsz = (nM - fm) < WGM ? (nM - fm) : WGM;
        u.pm = fm + ((wgid % nig) % gsz); u.pn = (wgid % nig) / gsz; return true;
    }
    __device__ __forceinline__ void a_ready(const Unit&) const {}
    __device__ __forceinline__ void done(const Unit&) const {}
};
template <class Epi, class Sched, bool STAMP = false>
__device__ __forceinline__ void gemm_phase(PG8_LAS unsigned char* lds, const Gemm g, const Sched& S, const Epi& E, unsigned long long* stamps) {
    const int tid = opq_tid(), wid = __builtin_amdgcn_readfirstlane(tid >> 6), lane = tid & 63, wr = wid >> 2, wc = wid & 3, fr = lane & 15, fq = lane >> 4;
    const int K = g.K, nt = K / BK;
    int ts_lo = 0, ts_hi = 0, nts = 0; const unsigned long long rt_entry = STAMP ? (unsigned long long)0 : 0ull;
#define PG8_STAMP() do { if (STAMP && wid == 0 && nts < 64) { const unsigned long long _c = (unsigned long long)clock64(); \
        ts_lo = (lane == nts) ? (int)(unsigned)_c : ts_lo; ts_hi = (lane == nts) ? (int)(unsigned)(_c >> 32) : ts_hi; ++nts; } } while (0)
    PG8_STAMP();
    unsigned voffA[2], voffB[2];
#pragma unroll
    for (int i = 0; i < 2; ++i) { int R, C; stage_rc(tid * 16 + i * 8192, R, C); const int Rb = Epi::PERM ? ((R & ~31) + perm32(R & 31)) : R;
        voffA[i] = (unsigned)(R * g.lda + C) * 2u; voffB[i] = (unsigned)(Rb * K + C) * 2u; }
    const size_t kstep = (size_t)(BK * 2);
    const size_t hstep = (size_t)HALF * K * 2, hstepA = (size_t)HALF * g.lda * 2;
    const size_t tstep = 2 * hstep, tstepA = 2 * hstepA;
    const unsigned ldsw = (unsigned)wid * 1024u;
    const int aoff = lds_byte(wr * 64 + fr, fq * 8), boff = lds_byte(wc * 32 + fr, fq * 8);
#define PG8_SA(b, h) (((b) * 2 + (h)) * HTB)
#define PG8_SB(b, h) ((4 + (b) * 2 + (h)) * HTB)
#define PG8_STAGE(bufoff, gbase, voff) do { _Pragma("unroll") for (int _i = 0; _i < 2; ++_i) \
        __builtin_amdgcn_global_load_lds((const unsigned*)((const char*)(gbase) + (voff)[_i]), (PG8_LAS unsigned*)(lds + (bufoff) + ldsw + _i * 8192), 16, 0, 0); } while (0)
#define PG8_LDA(dst, b, h) do { _Pragma("unroll") for (int m = 0; m < 4; ++m) _Pragma("unroll") for (int k = 0; k < 2; ++k) dst[m][k] = *(const PG8_LAS bf16x8*)(lds + PG8_SA(b, h) + aoff + m * 2048 + k * 1024); } while (0)
#define PG8_LDB(dst, b, h) do { _Pragma("unroll") for (int n = 0; n < 2; ++n) _Pragma("unroll") for (int k = 0; k < 2; ++k) dst[n][k] = *(const PG8_LAS bf16x8*)(lds + PG8_SB(b, h) + boff + n * 2048 + k * 1024); } while (0)
#define PG8_MMA(ai, bj, At, Bt) do { __builtin_amdgcn_s_setprio(1); _Pragma("unroll") for (int m = 0; m < 4; ++m) _Pragma("unroll") for (int n = 0; n < 2; ++n) _Pragma("unroll") for (int k = 0; k < 2; ++k) \
        acc[ai][bj][m][n] = __builtin_amdgcn_mfma_f32_16x16x32_bf16(Bt[n][k], At[m][k], acc[ai][bj][m][n], 0, 0, 0); __builtin_amdgcn_s_setprio(0); } while (0)
#define PG8_WAIT_V(n) asm volatile("s_waitcnt vmcnt(" #n ")" ::: "memory")
#define PG8_WAIT_L(n) asm volatile("s_waitcnt lgkmcnt(" #n ")" ::: "memory")
#define PG8_BAR __builtin_amdgcn_s_barrier()
#define PG8_SCHED __builtin_amdgcn_sched_barrier(0)
    Unit cur, nxt; int ui = 0;
    if (!S.next(0, cur)) return;
    f32x4 acc[2][2][4][2];
#pragma unroll
    for (int a = 0; a < 2; ++a)
#pragma unroll
        for (int b = 0; b < 2; ++b)
#pragma unroll
            for (int m = 0; m < 4; ++m)
#pragma unroll
                for (int n = 0; n < 2; ++n) acc[a][b][m][n] = (f32x4){0.f, 0.f, 0.f, 0.f};
    bf16x8 At[4][2], B0[2][2], B1[2][2];
    const char* cA = (const char*)g.A + (size_t)cur.pm * tstepA; const char* cB = (const char*)g.Bt + (size_t)cur.pn * tstep;
    S.a_ready(cur);
    PG8_STAGE(PG8_SB(0, 0), cB, voffB); PG8_STAGE(PG8_SA(0, 0), cA, voffA); PG8_STAGE(PG8_SB(0, 1), cB + hstep, voffB); PG8_STAGE(PG8_SA(0, 1), cA + hstepA, voffA);
    if (wr == 1) PG8_BAR;
    PG8_WAIT_V(4); PG8_BAR;
    PG8_STAGE(PG8_SB(1, 0), cB + kstep, voffB); PG8_STAGE(PG8_SA(1, 0), cA + kstep, voffA); PG8_STAGE(PG8_SB(1, 1), cB + hstep + kstep, voffB);
    PG8_WAIT_V(6); PG8_BAR;
    PG8_STAMP();
    for (;;) {
        const bool has_next = S.next(ui + 1, nxt);
        const char* nA = has_next ? (const char*)g.A + (size_t)nxt.pm * tstepA : cA; const char* nB = has_next ? (const char*)g.Bt + (size_t)nxt.pn * tstep : cB;
        for (int t = 0; t < nt; t += 2) {
            const bool last = (t == nt - 2);
            const char* a1 = cA + (size_t)(t + 1) * kstep;
            const char* a2 = last ? nA : cA + (size_t)(t + 2) * kstep; const char* b2 = last ? nB : cB + (size_t)(t + 2) * kstep;
            const char* a3 = a2 + kstep; const char* b3 = b2 + kstep;
            if (last && has_next) S.a_ready(nxt);
            PG8_LDB(B0, 0, 0); PG8_SCHED; PG8_LDA(At, 0, 0); PG8_STAGE(PG8_SA(1, 1), a1 + hstepA, voffA);
            PG8_WAIT_L(8); PG8_BAR; PG8_WAIT_L(0); PG8_MMA(0, 0, At, B0); PG8_BAR; PG8_SCHED;
            PG8_LDB(B1, 0, 1); PG8_STAGE(PG8_SB(0, 0), b2, voffB);
            PG8_BAR; PG8_WAIT_L(0); PG8_MMA(0, 1, At, B1); PG8_BAR;
            PG8_LDA(At, 0, 1); PG8_STAGE(PG8_SA(0, 0), a2, voffA);
            PG8_BAR; PG8_WAIT_L(0); PG8_MMA(1, 0, At, B0); PG8_BAR; PG8_SCHED;
            PG8_STAGE(PG8_SB(0, 1), b2 + hstep, voffB);
            PG8_WAIT_V(6); PG8_BAR; PG8_MMA(1, 1, At, B1); PG8_BAR;
            PG8_LDB(B0, 1, 0); PG8_SCHED; PG8_LDA(At, 1, 0); PG8_STAGE(PG8_SA(0, 1), a2 + hstepA, voffA);
            PG8_WAIT_L(8); PG8_BAR; PG8_WAIT_L(0); PG8_MMA(0, 0, At, B0); PG8_BAR; PG8_SCHED;
            PG8_LDB(B1, 1, 1); PG8_STAGE(PG8_SB(1, 0), b3, voffB);
            PG8_BAR; PG8_WAIT_L(0); PG8_MMA(0, 1, At, B1); PG8_BAR;
            PG8_LDA(At, 1, 1); PG8_STAGE(PG8_SA(1, 0), a3, voffA);
            PG8_BAR; PG8_WAIT_L(0); PG8_MMA(1, 0, At, B0); PG8_BAR; PG8_SCHED;
            PG8_STAGE(PG8_SB(1, 1), b3 + hstep, voffB);
            PG8_WAIT_V(6); PG8_BAR; PG8_MMA(1, 1, At, B1); PG8_BAR;
        }
        PG8_STAMP();
        if constexpr (!Epi::AFTER_DRAIN) { E(acc, cur, wr, wc, fr, fq); S.done(cur); }
        PG8_STAMP();
        if (!has_next) break;
#pragma unroll
        for (int a = 0; a < 2; ++a)
#pragma unroll
            for (int b = 0; b < 2; ++b)
#pragma unroll
                for (int m = 0; m < 4; ++m)
#pragma unroll
                    for (int n = 0; n < 2; ++n) acc[a][b][m][n] = (f32x4){0.f, 0.f, 0.f, 0.f};
        cur = nxt; cA = nA; cB = nB; ++ui;
    }
    PG8_WAIT_V(0);
    if (wr == 0) PG8_BAR;
    PG8_BAR;
    if constexpr (Epi::AFTER_DRAIN) { E.fused(acc, cur, wr, wc, fr, fq, lds, wid, lane); S.done(cur); }
    PG8_STAMP();
    if (STAMP && wid == 0) { stamps[lane] = lane < nts ? (((unsigned long long)(unsigned)ts_hi << 32) | (unsigned)ts_lo) : 0ull;
        if (lane == 62) stamps[62] = rt_entry; if (lane == 63) stamps[63] = (unsigned long long)0; }
#undef PG8_STAMP
#undef PG8_SA
#undef PG8_SB
#undef PG8_STAGE
#undef PG8_LDA
#undef PG8_LDB
#undef PG8_MMA
#undef PG8_WAIT_V
#undef PG8_WAIT_L
#undef PG8_BAR
#undef PG8_SCHED
}
}

typedef unsigned short bf16_t;
typedef short bf16x8 __attribute__((ext_vector_type(8)));
typedef float f32x4 __attribute__((ext_vector_type(4)));
typedef unsigned u32x4 __attribute__((ext_vector_type(4)));
typedef unsigned u32x2 __attribute__((ext_vector_type(2)));
#define DEV __device__ __forceinline__

constexpr int MTOK = 32768, DM = 1024, SEQ = 8192;
constexpr int LDE = 5376, LDO = 3072, LDF = 5632;
constexpr size_t MiB = (size_t)1 << 20;
constexpr size_t OFF_P = 0, OFF_HB = 352 * MiB, OFF_WT = 416 * MiB;
constexpr size_t W_INE = 0, W_OUTE = W_INE + (size_t)5376 * 1024, W_INO = W_OUTE + (size_t)1024 * 1024, W_OUTO = W_INO + (size_t)3072 * 1024,
                 W_UP0 = W_OUTO + (size_t)1024 * 1024, W_UP1 = W_UP0 + (size_t)5632 * 1024, W_DN0 = W_UP1 + (size_t)5632 * 1024, W_DN1 = W_DN0 + (size_t)1024 * 2816;
constexpr size_t OFF_THIN = 470 * MiB, OFF_HALO1 = OFF_THIN + 2 * MiB, OFF_HALO2 = OFF_HALO1 + 7 * MiB, OFF_GAM = OFF_HALO2 + 6 * MiB, OFF_BETA = OFF_GAM + MiB,
                 OFF_LSE = OFF_BETA + MiB, OFF_BLUT = OFF_LSE + 2 * MiB, OFF_CNT = OFF_BLUT + 32768, OFF_LAM = OFF_CNT + 256, OFF_BAR = OFF_LAM + 256, OFF_PARAMS = OFF_BAR + 16384, WS_NEED = OFF_PARAMS + 256;
constexpr float DN_ALPHA = 1.4142135623730951f;
constexpr float LAM_INIT = 0.35550906759f;
constexpr float LOG2E = 1.4426950408889634f;
constexpr int NLUT = 1536;

struct Params {
    const float *x, *rel_bias, *w_in_even, *gdn_conv_w, *gdn_a_log, *gdn_dt_bias, *gdn_norm_w, *w_out_even, *w_in_odd, *diff_lambda, *diff_norm_w, *gla_w_gate,
        *gla_b_gate, *gla_norm_w, *w_out_odd, *ffn_w_up, *ffn_conv_w, *ffn_conv_b, *ffn_w_down, *ln_g, *ln_b;
    float* out; unsigned char* ws;
};

DEV const void* gparam(const unsigned char* ws, int idx) {
    const unsigned long long v = ((const unsigned long long*)(ws + OFF_PARAMS))[idx];
    const unsigned lo = __builtin_amdgcn_readfirstlane((unsigned)v), hi = __builtin_amdgcn_readfirstlane((unsigned)(v >> 32));
    return (const void*)(((unsigned long long)hi << 32) | lo);
}
DEV Params load_params(unsigned char* ws) {
    Params q;
    const float** f = (const float**)&q;
#pragma unroll
    for (int i = 0; i < 21; ++i) f[i] = (const float*)gparam(ws, i);
    q.out = (float*)gparam(ws, 21); q.ws = ws;
    return q;
}
DEV float lo2f(unsigned w) { return __uint_as_float(w << 16); }
DEV float hi2f(unsigned w) { return __uint_as_float(w & 0xffff0000u); }
DEV float bf2f(bf16_t b) { return __uint_as_float(((unsigned)b) << 16); }
typedef __bf16 bf16v2_t __attribute__((ext_vector_type(2)));
typedef float f32v2_t __attribute__((ext_vector_type(2)));
DEV unsigned pk2(float lo, float hi) { const f32v2_t v = {lo, hi}; const bf16v2_t b = __builtin_convertvector(v, bf16v2_t); return __builtin_bit_cast(unsigned, b); }
DEV bf16_t f2bf(float f) { return (bf16_t)(pk2(f, 0.f) & 0xffffu); }
DEV bf16x8 mk8(unsigned a, unsigned b, unsigned c, unsigned d) { u32x4 v = {a, b, c, d}; return __builtin_bit_cast(bf16x8, v); }
DEV f32x4 mfma16(bf16x8 a, bf16x8 b, f32x4 c) { return __builtin_amdgcn_mfma_f32_16x16x32_bf16(a, b, c, 0, 0, 0); }
DEV bf16x8 ld8(const bf16_t* p) { return *(const bf16x8*)p; }
DEV bf16x8 ldperm(const bf16_t* p) { const u32x2 lo = *(const u32x2*)p, hi = *(const u32x2*)(p + 16); return mk8(lo.x, lo.y, hi.x, hi.y); }
DEV bf16x8 pk8(f32x4 a, f32x4 b) { return mk8(pk2(a[0], a[1]), pk2(a[2], a[3]), pk2(b[0], b[1]), pk2(b[2], b[3])); }
DEV float silu(float x) { return x * __builtin_amdgcn_rcpf(1.0f + __expf(-x)); }
DEV float ex2(float x) { return __builtin_amdgcn_exp2f(x); }
DEV float dpp_f(float v, int ctrl_b1) { return v; }
DEV float rsum16(float v) {
    v += __int_as_float(__builtin_amdgcn_update_dpp(0, __float_as_int(v), 0xB1, 0xf, 0xf, true));
    v += __int_as_float(__builtin_amdgcn_update_dpp(0, __float_as_int(v), 0x4E, 0xf, 0xf, true));
    v += __int_as_float(__builtin_amdgcn_update_dpp(0, __float_as_int(v), 0x141, 0xf, 0xf, true));
    v += __int_as_float(__builtin_amdgcn_update_dpp(0, __float_as_int(v), 0x140, 0xf, 0xf, true));
    return v;
}
DEV float wsum(float v) { v = rsum16(v); v += __shfl_xor(v, 16); v += __shfl_xor(v, 32); return v; }

struct EpiStoreBf16 {
    static constexpr bool PERM = true, AFTER_DRAIN = false;
    bf16_t* O; int ldc; bf16_t* halo; int seg, hrows, hcols;
    __device__ __forceinline__ void operator()(const f32x4 (&acc)[2][2][4][2], const pg8::Unit& u, int wr, int wc, int fr, int fq) const {
        const int row0 = u.pm * 256 + wr * 64 + fr, col0 = u.pn * 256 + wc * 32 + 8 * fq;
#pragma unroll
        for (int ai = 0; ai < 2; ++ai)
#pragma unroll
            for (int m = 0; m < 4; ++m) {
                const int row = row0 + ai * 128 + m * 16; bf16_t* rowp = O + (size_t)row * ldc + col0;
                const int rs = row & (seg - 1); const bool hal = rs >= seg - hrows;
#pragma unroll
                for (int bj = 0; bj < 2; ++bj) {
                    const f32x4 v0 = acc[ai][bj][m][0], v1 = acc[ai][bj][m][1];
                    u32x4 w; w.x = pk2(v0[0], v0[1]); w.y = pk2(v0[2], v0[3]); w.z = pk2(v1[0], v1[1]); w.w = pk2(v1[2], v1[3]);
                    *(u32x4*)(rowp + bj * 128) = w;
                    if (hal && col0 + bj * 128 < hcols) *(u32x4*)(halo + ((size_t)(row / seg) * hrows + (rs - (seg - hrows))) * hcols + col0 + bj * 128) = w;
                }
            }
    }
};
struct EpiResF32 {
    static constexpr bool PERM = false, AFTER_DRAIN = false;
    const float* base; float* out; int ldc; float alpha;
    __device__ __forceinline__ void operator()(const f32x4 (&acc)[2][2][4][2], const pg8::Unit& u, int wr, int wc, int fr, int fq) const {
        const int row0 = u.pm * 256 + wr * 64 + fr, col0 = u.pn * 256 + wc * 32 + 4 * fq;
#pragma unroll
        for (int ai = 0; ai < 2; ++ai)
#pragma unroll
            for (int mp = 0; mp < 2; ++mp) {
                f32x4 bs[2][2][2];
#pragma unroll
                for (int mm = 0; mm < 2; ++mm) {
                    const size_t off = (size_t)(row0 + ai * 128 + (2 * mp + mm) * 16) * ldc + col0;
#pragma unroll
                    for (int bj = 0; bj < 2; ++bj)
#pragma unroll
                        for (int n = 0; n < 2; ++n) bs[mm][bj][n] = *(const f32x4*)(base + off + bj * 128 + n * 16);
                }
#pragma unroll
                for (int mm = 0; mm < 2; ++mm) {
                    const size_t off = (size_t)(row0 + ai * 128 + (2 * mp + mm) * 16) * ldc + col0;
#pragma unroll
                    for (int bj = 0; bj < 2; ++bj)
#pragma unroll
                        for (int n = 0; n < 2; ++n) *(f32x4*)(out + off + bj * 128 + n * 16) = bs[mm][bj][n] * alpha + acc[ai][bj][2 * mp + mm][n];
                }
                asm volatile("" ::: "memory");
            }
    }
};
template <class Epi> DEV void run_gemm(int gemm_c, const bf16_t* A, int lda, const bf16_t* Bt, int M, int N, int K, const Epi& E) {
    pg8::Gemm g; g.A = A; g.Bt = Bt; g.M = M; g.N = N; g.K = K; g.lda = lda;
    pg8::StaticOrder S; S.init(M, N, (int)gridDim.x, gemm_c);
    pg8::gemm_phase<Epi, pg8::StaticOrder, false>((PG8_LAS unsigned char*)g_shm, g, S, E, nullptr);
}

DEV void cvt_tile(const float* src, int ld, int K, int srcn0, int k0, bf16_t* dst, int dstn0) {
    float* tile = (float*)g_shm; const int tid = opq_tid();
#pragma unroll
    for (int i = 0; i < 2; ++i) { const int idx = tid + 512 * i, kk = idx >> 4, n4 = (idx & 15) * 4; const float4 v = *(const float4*)(src + (size_t)(k0 + kk) * ld + srcn0 + n4);
        tile[kk * 65 + n4] = v.x; tile[kk * 65 + n4 + 1] = v.y; tile[kk * 65 + n4 + 2] = v.z; tile[kk * 65 + n4 + 3] = v.w; }
    __syncthreads();
    { const int n = tid >> 3, k8 = (tid & 7) * 8; float v[8];
#pragma unroll
      for (int j = 0; j < 8; ++j) v[j] = tile[(k8 + j) * 65 + n];
      u32x4 w; w.x = pk2(v[0], v[1]); w.y = pk2(v[2], v[3]); w.z = pk2(v[4], v[5]); w.w = pk2(v[6], v[7]);
      *(u32x4*)(dst + (size_t)(dstn0 + n) * K + k0 + k8) = w; }
    __syncthreads();
}
DEV void cvt_weight_tile(const Params& p, int t) {
    bf16_t* WT = (bf16_t*)(p.ws + OFF_WT);
    {
        const float* src; int ld, K, nt; bf16_t* dst; int shift = 0; int lt = t;
        if (lt < 1344) { src = p.w_in_even; ld = 5388; K = 1024; nt = 84; dst = WT + W_INE; shift = 12; }
        else if ((lt -= 1344) < 256) { src = p.w_out_even; ld = 1024; K = 1024; nt = 16; dst = WT + W_OUTE; }
        else if ((lt -= 256) < 768) { src = p.w_in_odd; ld = 3088; K = 1024; nt = 48; dst = WT + W_INO; }
        else if ((lt -= 768) < 256) { src = p.w_out_odd; ld = 1024; K = 1024; nt = 16; dst = WT + W_OUTO; }
        else if ((lt -= 256) < 1408) { src = p.ffn_w_up; ld = 5632; K = 1024; nt = 88; dst = WT + W_UP0; }
        else if ((lt -= 1408) < 1408) { src = p.ffn_w_up + (size_t)1024 * 5632; ld = 5632; K = 1024; nt = 88; dst = WT + W_UP1; }
        else if ((lt -= 1408) < 704) { src = p.ffn_w_down; ld = 1024; K = 2816; nt = 16; dst = WT + W_DN0; }
        else { lt -= 704; src = p.ffn_w_down + (size_t)2816 * 1024; ld = 1024; K = 2816; nt = 16; dst = WT + W_DN1; }
        const int ntile = lt % nt, ktile = lt / nt; const int n0 = ntile * 64; const int srcn0 = (n0 >= 3072) ? n0 + shift : n0;
        cvt_tile(src, ld, K, srcn0, ktile * 64, dst, n0);
    }
}
DEV void phase_weights(const Params& p) {
#pragma unroll 1
    for (int t = blockIdx.x; t < 1600; t += gridDim.x) cvt_weight_tile(p, t);
    if (blockIdx.x == 0) {
        if (threadIdx.x < 22) { const void* const* src = (const void* const*)&p; ((const void**)(p.ws + OFF_PARAMS))[threadIdx.x] = src[threadIdx.x]; }
        float* blut = (float*)(p.ws + OFF_BLUT);
        for (int d = threadIdx.x; d < NLUT; d += 512) {
            int bk;
            if (d < 16) bk = d; else { const float lg = logf((float)d / 16.0f) / 4.852030263919617f * 16.0f; bk = 16 + (int)lg; if (bk > 31) bk = 31; }
            for (int h = 0; h < 4; ++h) blut[h * NLUT + d] = p.rel_bias[bk * 4 + h];
        }
        if (threadIdx.x == 0) {
            float s1 = 0.f, s2 = 0.f; for (int i = 0; i < 64; ++i) { s1 += p.diff_lambda[i] * p.diff_lambda[64 + i]; s2 += p.diff_lambda[128 + i] * p.diff_lambda[192 + i]; }
            *(float*)(p.ws + OFF_LAM) = expf(s1) - expf(s2) + LAM_INIT;
            *(unsigned*)(p.ws + OFF_CNT) = 0u; *(unsigned*)(p.ws + OFF_CNT + 64) = 0u; *(unsigned*)(p.ws + OFF_CNT + 128) = 0u;
        }
    }
}

DEV void rowpass(const float* src, const bf16_t* mix, float* dst, bf16_t* hb, const float* lg, const float* lb, const float* wthin, int ldw, int nc, float* thin) {
    float* W = (float*)g_shm; const int tid = opq_tid(), wid = tid >> 6, lane = tid & 63;
    __syncthreads();
    if (nc > 0) {
        for (int idx = tid; idx < 16384; idx += 512) { const int k = idx >> 4, c = idx & 15; const int i = k >> 8, ln = (k & 255) >> 2, j = k & 3, c4 = c >> 2, cc = c & 3;
            W[((((i * 4 + j) * 4 + c4) * 64 + ln) * 4) + cc] = c < nc ? wthin[(size_t)k * ldw + c] : 0.f; }
    }
    __syncthreads();
    f32x4 v[4], vn[4]; u32x2 mn[4];
    {
        const int r0 = blockIdx.x * 8 + wid;
#pragma unroll
        for (int i = 0; i < 4; ++i) { vn[i] = (f32x4){0.f, 0.f, 0.f, 0.f}; mn[i] = (u32x2){0u, 0u}; if (r0 < MTOK) { vn[i] = *(const f32x4*)(src + (size_t)r0 * DM + i * 256 + lane * 4);
            if (mix) mn[i] = *(const u32x2*)(mix + (size_t)r0 * LDF + i * 256 + lane * 4); } }
    }
#pragma unroll 1
    for (int rb = blockIdx.x * 8 + wid; rb < MTOK; rb += gridDim.x * 8) {
        const int r = rb, rn = rb + (int)gridDim.x * 8;
#pragma unroll
        for (int i = 0; i < 4; ++i) { v[i] = vn[i]; if (mix) { v[i] = v[i] * DN_ALPHA + (f32x4){lo2f(mn[i].x), hi2f(mn[i].x), lo2f(mn[i].y), hi2f(mn[i].y)}; } }
        if (rn < MTOK) {
#pragma unroll
            for (int i = 0; i < 4; ++i) { vn[i] = *(const f32x4*)(src + (size_t)rn * DM + i * 256 + lane * 4); if (mix) mn[i] = *(const u32x2*)(mix + (size_t)rn * LDF + i * 256 + lane * 4); }
        }
        if (lg) {
            float s = 0.f;
#pragma unroll
            for (int i = 0; i < 4; ++i) s += (v[i][0] + v[i][1]) + (v[i][2] + v[i][3]);
            const float mu = wsum(s) * (1.0f / 1024.0f); float q = 0.f;
#pragma unroll
            for (int i = 0; i < 4; ++i) { const f32x4 d = v[i] - mu; q += (d[0] * d[0] + d[1] * d[1]) + (d[2] * d[2] + d[3] * d[3]); }
            const float rstd = rsqrtf(wsum(q) * (1.0f / 1024.0f) + 1e-5f);
#pragma unroll
            for (int i = 0; i < 4; ++i) { const f32x4 gg = *(const f32x4*)(lg + i * 256 + lane * 4), bb = *(const f32x4*)(lb + i * 256 + lane * 4); v[i] = (v[i] - mu) * rstd * gg + bb; }
        }
#pragma unroll
        for (int i = 0; i < 4; ++i) {
            if (dst) *(f32x4*)(dst + (size_t)r * DM + i * 256 + lane * 4) = v[i];
            if (hb) { u32x2 w; w.x = pk2(v[i][0], v[i][1]); w.y = pk2(v[i][2], v[i][3]); *(u32x2*)(hb + (size_t)r * DM + i * 256 + lane * 4) = w; }
        }
        if (nc > 0) {
            f32x4 a4[4];
#pragma unroll
            for (int c4 = 0; c4 < 4; ++c4) a4[c4] = (f32x4){0.f, 0.f, 0.f, 0.f};
#pragma unroll
            for (int i = 0; i < 4; ++i)
#pragma unroll
                for (int j = 0; j < 4; ++j) {
                    const float yv = v[i][j];
#pragma unroll
                    for (int c4 = 0; c4 < 4; ++c4) a4[c4] += *(const f32x4*)(W + (((i * 4 + j) * 4 + c4) * 64 + lane) * 4) * yv;
                    asm volatile("" ::: "memory");
                }
#pragma unroll
            for (int c4 = 0; c4 < 4; ++c4)
#pragma unroll
                for (int cc = 0; cc < 4; ++cc) { const float t = wsum(a4[c4][cc]); if (lane == c4 * 4 + cc) thin[(size_t)r * 16 + lane] = t; }
        }
    }
    __syncthreads();
}

DEV void convgate(const Params& p, int layer) {
    bf16_t* P = (bf16_t*)(p.ws + OFF_P); const bf16_t* halo = (const bf16_t*)(p.ws + OFF_HALO2);
    const float* cw = p.ffn_conv_w + (size_t)layer * 3 * 5632; const float* cb = p.ffn_conv_b + (size_t)layer * 5632;
    const int tid = opq_tid();
    if (tid >= 352) return;
    const int c0 = tid * 8;
    float wg[3][8], wv[3][8], bg[8], bv[8];
#pragma unroll
    for (int j = 0; j < 3; ++j)
#pragma unroll
        for (int e = 0; e < 8; ++e) { wg[j][e] = cw[j * 5632 + c0 + e]; wv[j][e] = cw[j * 5632 + 2816 + c0 + e]; }
#pragma unroll
    for (int e = 0; e < 8; ++e) { bg[e] = cb[c0 + e]; bv[e] = cb[2816 + c0 + e]; }
#pragma unroll 1
    for (int seg = blockIdx.x; seg < 256; seg += gridDim.x) {
        u32x4 g1, g2, v1, v2;
        if ((seg & 63) == 0) { g1 = g2 = v1 = v2 = (u32x4){0u, 0u, 0u, 0u}; }
        else { const bf16_t* hp = halo + (size_t)(seg - 1) * 2 * 5632; g1 = *(const u32x4*)(hp + c0); v1 = *(const u32x4*)(hp + 2816 + c0); g2 = *(const u32x4*)(hp + 5632 + c0); v2 = *(const u32x4*)(hp + 5632 + 2816 + c0); }
        bf16_t* base = P + (size_t)seg * 128 * LDF;
#pragma unroll 1
        for (int t4 = 0; t4 < 128; t4 += 8) {
            u32x4 gr[8], vr[8];
#pragma unroll
            for (int q = 0; q < 8; ++q) { gr[q] = *(const u32x4*)(base + (size_t)(t4 + q) * LDF + c0); vr[q] = *(const u32x4*)(base + (size_t)(t4 + q) * LDF + 2816 + c0); }
#pragma unroll
            for (int q = 0; q < 8; ++q) {
                const u32x4 g3 = gr[q], v3 = vr[q]; u32x4 o;
#pragma unroll
                for (int w = 0; w < 4; ++w) {
                    const float G0 = wg[0][2 * w] * lo2f(g1[w]) + wg[1][2 * w] * lo2f(g2[w]) + wg[2][2 * w] * lo2f(g3[w]) + bg[2 * w];
                    const float G1 = wg[0][2 * w + 1] * hi2f(g1[w]) + wg[1][2 * w + 1] * hi2f(g2[w]) + wg[2][2 * w + 1] * hi2f(g3[w]) + bg[2 * w + 1];
                    const float V0 = wv[0][2 * w] * lo2f(v1[w]) + wv[1][2 * w] * lo2f(v2[w]) + wv[2][2 * w] * lo2f(v3[w]) + bv[2 * w];
                    const float V1 = wv[0][2 * w + 1] * hi2f(v1[w]) + wv[1][2 * w + 1] * hi2f(v2[w]) + wv[2][2 * w + 1] * hi2f(v3[w]) + bv[2 * w + 1];
                    o[w] = pk2(silu(G0) * V0, silu(G1) * V1);
                }
                *(u32x4*)(base + (size_t)(t4 + q) * LDF + c0) = o;
                g1 = g2; g2 = g3; v1 = v2; v2 = v3;
            }
        }
    }
}

template <int BASE> DEV void solve32(const float* As, float* Tm, int lane) {
    const int c = lane & 31;
    float t[32];
#pragma unroll
    for (int i = 0; i < 32; ++i) t[i] = 0.f;
#pragma unroll
    for (int i = 0; i < 32; ++i) {
        float sv = (i == c) ? 1.f : 0.f;
#pragma unroll
        for (int j4 = 0; j4 < (i + 3) / 4; ++j4) { const f32x4 a = *(const f32x4*)(As + (BASE + i) * 68 + BASE + j4 * 4);
            sv -= a[0] * t[4 * j4]; sv -= a[1] * t[4 * j4 + 1]; sv -= a[2] * t[4 * j4 + 2]; sv -= a[3] * t[4 * j4 + 3]; }
        t[i] = sv;
        if (lane < 32) { Tm[(BASE + i) * 68 + BASE + c] = sv; if (BASE == 0) Tm[i * 68 + 32 + c] = 0.f; }
        asm volatile("" ::: "memory");
    }
}

DEV void gdn_prep(const Params& p) {
    bf16_t* P = (bf16_t*)(p.ws + OFF_P);
    const float* thin = (const float*)(p.ws + OFF_THIN);
    const bf16_t* halo = (const bf16_t*)(p.ws + OFF_HALO1);
    float* gamG = (float*)(p.ws + OFF_GAM); float* betaG = (float*)(p.ws + OFF_BETA);
    bf16_t* Tg = (bf16_t*)p.out; bf16_t* QKg = Tg + (size_t)3072 * 4096; bf16_t* kTg = QKg + (size_t)3072 * 4096;
    bf16_t* Qs = (bf16_t*)g_shm; bf16_t* Ks = Qs + 64 * 136; float* As = (float*)(g_shm + 2 * 17408); float* gamS = As + 64 * 68; float* betaS = gamS + 64;
#pragma unroll 1
    for (int it0 = blockIdx.x; it0 < 3072; it0 += gridDim.x) {
        const int tid = opq_tid(), wid = tid >> 6, lane = tid & 63, fr = lane & 15, fq = lane >> 4;
        const int h = it0 % 6, bn = it0 / 6, n = bn & 127, b = bn >> 7;
        const int item = (b * 6 + h) * 128 + n;
        const int t0 = b * SEQ + n * 64;
        u32x4 keep[6];
#pragma unroll
        for (int u6 = 0; u6 < 6; ++u6) {
            const int mat = u6 >> 1, r = (u6 & 1) * 32 + (tid >> 4), cg8 = (tid & 15) * 8;
            const int col = mat * 768 + h * 128 + cg8;
            float y[8];
#pragma unroll
            for (int e = 0; e < 8; ++e) y[e] = 0.f;
#pragma unroll
            for (int j = 0; j < 4; ++j) {
                const int rr = r - 3 + j;
                u32x4 raw = (u32x4){0u, 0u, 0u, 0u};
                if (rr >= 0) raw = *(const u32x4*)(P + (size_t)(t0 + rr) * LDE + col);
                else if (n > 0) raw = *(const u32x4*)(halo + ((size_t)(b * 128 + n - 1) * 3 + (rr + 3)) * 2304 + col);
                const f32x4 w0 = *(const f32x4*)(p.gdn_conv_w + j * 2304 + col), w1 = *(const f32x4*)(p.gdn_conv_w + j * 2304 + col + 4);
                y[0] += w0[0] * lo2f(raw.x); y[1] += w0[1] * hi2f(raw.x); y[2] += w0[2] * lo2f(raw.y); y[3] += w0[3] * hi2f(raw.y);
                y[4] += w1[0] * lo2f(raw.z); y[5] += w1[1] * hi2f(raw.z); y[6] += w1[2] * lo2f(raw.w); y[7] += w1[3] * hi2f(raw.w);
            }
            float ss = 0.f;
#pragma unroll
            for (int e = 0; e < 8; ++e) { y[e] = silu(y[e]); ss += y[e] * y[e]; }
            if (mat < 2) {
                ss = rsum16(ss);
                const float inv = rsqrtf(ss + 1e-6f) * (mat == 0 ? 0.08838834764831845f : 1.0f);
#pragma unroll
                for (int e = 0; e < 8; ++e) y[e] *= inv;
            }
            u32x4 w; w.x = pk2(y[0], y[1]); w.y = pk2(y[2], y[3]); w.z = pk2(y[4], y[5]); w.w = pk2(y[6], y[7]);
            keep[u6] = w;
            if (mat == 0) *(u32x4*)(Qs + r * 136 + cg8) = w;
            if (mat == 1) *(u32x4*)(Ks + r * 136 + cg8) = w;
        }
        if (wid == 0) {
            const int t = t0 + lane;
            const float ba = thin[(size_t)t * 16 + h], aa = thin[(size_t)t * 16 + 6 + h];
            const float beta = 1.0f / (1.0f + expf(-ba));
            const float xx = aa + p.gdn_dt_bias[h];
            const float sp = xx > 20.f ? xx : log1pf(expf(xx));
            float g = -expf(p.gdn_a_log[h]) * sp;
#pragma unroll
            for (int o = 1; o < 64; o <<= 1) { const float tt = __shfl_up(g, o); if (lane >= o) g += tt; }
            gamS[lane] = g; betaS[lane] = beta;
            gamG[(size_t)(b * 6 + h) * SEQ + n * 64 + lane] = g; betaG[(size_t)(b * 6 + h) * SEQ + n * 64 + lane] = beta;
        }
        __syncthreads();
        {
            const int mtx = wid >> 2, itile = wid & 3; const bf16_t* X = mtx ? Qs : Ks;
#pragma unroll
            for (int jt = 0; jt < 4; ++jt) {
                f32x4 acc = (f32x4){0.f, 0.f, 0.f, 0.f};
                if (jt <= itile) {
#pragma unroll
                    for (int kb = 0; kb < 4; ++kb) acc = mfma16(ld8(X + (16 * itile + fr) * 136 + kb * 32 + fq * 8), ld8(Ks + (16 * jt + fr) * 136 + kb * 32 + fq * 8), acc);
                }
#pragma unroll
                for (int jj = 0; jj < 4; ++jj) {
                    const int i = 16 * itile + 4 * fq + jj, j = 16 * jt + fr;
                    const float dec = (i >= j) ? __expf(gamS[i] - gamS[j]) : 0.f;
                    if (mtx == 0) As[i * 68 + j] = (i > j) ? betaS[i] * acc[jj] * dec : 0.f;
                    else QKg[(size_t)item * 4096 + i * 64 + j] = f2bf(acc[jj] * dec);
                }
            }
        }
        __syncthreads();
#pragma unroll
        for (int u6 = 0; u6 < 6; ++u6) {
            const int mat = u6 >> 1, r = (u6 & 1) * 32 + (tid >> 4), cg8 = (tid & 15) * 8;
            *(u32x4*)(P + (size_t)(t0 + r) * LDE + mat * 768 + h * 128 + cg8) = keep[u6];
        }
        {
            const int dk = tid >> 2, c0 = (tid & 3) * 16; unsigned w[8];
#pragma unroll
            for (int e = 0; e < 8; ++e) w[e] = (unsigned)Ks[(c0 + 2 * e) * 136 + dk] | ((unsigned)Ks[(c0 + 2 * e + 1) * 136 + dk] << 16);
            u32x4 a = {w[0], w[1], w[2], w[3]}, bq = {w[4], w[5], w[6], w[7]};
            *(u32x4*)(kTg + (size_t)item * 8192 + dk * 64 + c0) = a; *(u32x4*)(kTg + (size_t)item * 8192 + dk * 64 + c0 + 8) = bq;
        }
        {
            float* Tm = betaS + 64; float* Xm = Tm + 64 * 68;
            if (wid == 0) solve32<0>(As, Tm, lane);
            else if (wid == 1) solve32<32>(As, Tm, lane);
            __syncthreads();
            {
                const int i = tid >> 4, c0 = (tid & 15) * 2; float x0 = 0.f, x1 = 0.f;
#pragma unroll 8
                for (int j = 0; j < 32; ++j) { const float a = As[(32 + i) * 68 + j]; x0 += a * Tm[j * 68 + c0]; x1 += a * Tm[j * 68 + c0 + 1]; }
                Xm[i * 36 + c0] = x0; Xm[i * 36 + c0 + 1] = x1;
            }
            __syncthreads();
            {
                const int i = tid >> 4, c0 = (tid & 15) * 2; float x0 = 0.f, x1 = 0.f;
#pragma unroll 8
                for (int j = 0; j < 32; ++j) { const float a = Tm[(32 + i) * 68 + 32 + j]; x0 -= a * Xm[j * 36 + c0]; x1 -= a * Xm[j * 36 + c0 + 1]; }
                Tm[(32 + i) * 68 + c0] = x0; Tm[(32 + i) * 68 + c0 + 1] = x1;
            }
            __syncthreads();
            {
                const int row = tid >> 3, col = (tid & 7) * 8; const f32x4 a = *(const f32x4*)(Tm + row * 68 + col), b2 = *(const f32x4*)(Tm + row * 68 + col + 4);
                u32x4 w; w.x = pk2(a[0], a[1]); w.y = pk2(a[2], a[3]); w.z = pk2(b2[0], b2[1]); w.w = pk2(b2[2], b2[3]);
                *(u32x4*)(Tg + (size_t)item * 4096 + tid * 8) = w;
            }
        }
        __syncthreads();
    }
}

DEV void gdn_scan(const Params& p, int task) {
    const bf16_t* P = (const bf16_t*)(p.ws + OFF_P);
    const float* gamG = (const float*)(p.ws + OFF_GAM); const float* betaG = (const float*)(p.ws + OFF_BETA);
    const bf16_t* Tg = (const bf16_t*)p.out; const bf16_t* QKg = Tg + (size_t)3072 * 4096; const bf16_t* kTg = QKg + (size_t)3072 * 4096;
    bf16_t* mo = (bf16_t*)(p.ws + OFF_HB);
    bf16_t* Kc = (bf16_t*)g_shm; bf16_t* Qc = Kc + 64 * 136; bf16_t* KT = Qc + 64 * 136; bf16_t* Tm = KT + 128 * 72; bf16_t* QK = Tm + 64 * 72; float* gamS = (float*)(QK + 64 * 72); float* betaS = gamS + 64; bf16_t* Vs = (bf16_t*)(betaS + 64);
    const int tid = opq_tid(), wid = tid >> 6, lane = tid & 63, fr = lane & 15, fq = lane >> 4;
    const int bh = task >> 2, quarter = task & 3, b = bh / 6, h = bh % 6;
    const size_t tok0 = (size_t)b * SEQ;
    const int dv = quarter * 32 + (wid & 1) * 16 + fr;
    u32x4 rK[2], rQ[2], rKT[2], rT, rQK, rV = (u32x4){0u, 0u, 0u, 0u}; float rg = 0.f, rb = 0.f;
    f32x4 S[8];
#pragma unroll
    for (int t = 0; t < 8; ++t) S[t] = (f32x4){0.f, 0.f, 0.f, 0.f};
#define GDN_LOAD(n_) do { const int n__ = (n_); const size_t item__ = (size_t)bh * 128 + n__; \
        _Pragma("unroll") for (int i = 0; i < 2; ++i) { const int idx = tid + 512 * i, r = idx >> 4, c8 = (idx & 15) * 8; \
            rK[i] = *(const u32x4*)(P + (tok0 + n__ * 64 + r) * LDE + 768 + h * 128 + c8); rQ[i] = *(const u32x4*)(P + (tok0 + n__ * 64 + r) * LDE + h * 128 + c8); \
            rKT[i] = *(const u32x4*)(kTg + item__ * 8192 + (size_t)idx * 8); } \
        rT = *(const u32x4*)(Tg + item__ * 4096 + (size_t)tid * 8); rQK = *(const u32x4*)(QKg + item__ * 4096 + (size_t)tid * 8); \
        if (tid < 256) rV = *(const u32x4*)(P + (tok0 + n__ * 64 + (tid >> 2)) * LDE + 1536 + h * 128 + quarter * 32 + (tid & 3) * 8); \
        if (tid < 64) { rg = gamG[(size_t)bh * SEQ + n__ * 64 + tid]; rb = betaG[(size_t)bh * SEQ + n__ * 64 + tid]; } } while (0)
#define GDN_STORE() do { \
        _Pragma("unroll") for (int i = 0; i < 2; ++i) { const int idx = tid + 512 * i, r = idx >> 4, c8 = (idx & 15) * 8; \
            *(u32x4*)(Kc + r * 136 + c8) = rK[i]; *(u32x4*)(Qc + r * 136 + c8) = rQ[i]; *(u32x4*)(KT + (idx >> 3) * 72 + (idx & 7) * 8) = rKT[i]; } \
        *(u32x4*)(Tm + (tid >> 3) * 72 + (tid & 7) * 8) = rT; *(u32x4*)(QK + (tid >> 3) * 72 + (tid & 7) * 8) = rQK; \
        if (tid < 256) *(u32x4*)(Vs + (tid >> 2) * 40 + (tid & 3) * 8) = rV; \
        if (tid < 64) { gamS[tid] = rg; betaS[tid] = rb; egS[tid] = __expf(rg); edS[tid] = __expf(__int_as_float(__builtin_amdgcn_readlane(__float_as_int(rg), 63)) - rg); } } while (0)
    bf16x8* exS = (bf16x8*)(Vs + 64 * 40);
    bf16x8* exD = exS + 2 * 4 * 64;
    float* egS = (float*)(exD + 2 * 2 * 64); float* edS = egS + 64;
    const int slice = wid & 1;
    __syncthreads();
    GDN_LOAD(0); GDN_STORE();
    if (wid < 2) {
#pragma unroll
        for (int kb = 0; kb < 4; ++kb) exS[(slice * 4 + kb) * 64 + lane] = pk8(S[2 * kb], S[2 * kb + 1]);
    }
    __syncthreads();
    bf16x8 bE0 = pk8(S[0], S[0]), bE1 = bE0; float gl = 0.f;
    f32x4 QS[4];
#pragma unroll
    for (int rt = 0; rt < 4; ++rt) QS[rt] = (f32x4){0.f, 0.f, 0.f, 0.f};
#pragma unroll 1
    for (int n = 0; n < 128; ++n) {
        if (n + 1 < 128) { GDN_LOAD(n + 1); }
        if (wid < 2) {
            bf16x8 bS[4];
#pragma unroll
            for (int kb = 0; kb < 4; ++kb) bS[kb] = pk8(S[2 * kb], S[2 * kb + 1]);
            f32x4 KS[4];
#pragma unroll
            for (int rt = 0; rt < 4; ++rt) {
                f32x4 a = (f32x4){0.f, 0.f, 0.f, 0.f};
#pragma unroll
                for (int kb = 0; kb < 4; ++kb) a = mfma16(ldperm(Kc + (16 * rt + fr) * 136 + 32 * kb + 4 * fq), bS[kb], a);
                KS[rt] = a;
            }
            gl = egS[63];
            f32x4 R[4];
#pragma unroll
            for (int rt = 0; rt < 4; ++rt)
#pragma unroll
                for (int jj = 0; jj < 4; ++jj) {
                    const int i = 16 * rt + 4 * fq + jj;
                    R[rt][jj] = betaS[i] * (bf2f(Vs[i * 40 + slice * 16 + fr]) - egS[i] * KS[rt][jj]);
                }
            const bf16x8 bR0 = pk8(R[0], R[1]), bR1 = pk8(R[2], R[3]);
            f32x4 D[4];
#pragma unroll
            for (int rt = 0; rt < 4; ++rt) {
                f32x4 a = (f32x4){0.f, 0.f, 0.f, 0.f};
                a = mfma16(ldperm(Tm + (16 * rt + fr) * 72 + 4 * fq), bR0, a);
                a = mfma16(ldperm(Tm + (16 * rt + fr) * 72 + 32 + 4 * fq), bR1, a);
                D[rt] = a;
            }
            exD[(slice * 2 + 0) * 64 + lane] = pk8(D[0], D[1]); exD[(slice * 2 + 1) * 64 + lane] = pk8(D[2], D[3]);
#pragma unroll
            for (int rt = 0; rt < 4; ++rt)
#pragma unroll
                for (int jj = 0; jj < 4; ++jj) D[rt][jj] *= edS[16 * rt + 4 * fq + jj];
            bE0 = pk8(D[0], D[1]); bE1 = pk8(D[2], D[3]);
        } else if (wid < 4) {
            bf16x8 bS[4];
#pragma unroll
            for (int kb = 0; kb < 4; ++kb) bS[kb] = exS[(slice * 4 + kb) * 64 + lane];
#pragma unroll
            for (int rt = 0; rt < 4; ++rt) {
                f32x4 a = (f32x4){0.f, 0.f, 0.f, 0.f};
#pragma unroll
                for (int kb = 0; kb < 4; ++kb) a = mfma16(ldperm(Qc + (16 * rt + fr) * 136 + 32 * kb + 4 * fq), bS[kb], a);
                QS[rt] = a;
            }
        }
        __syncthreads();
        if (wid < 2) {
            const float egl = gl;
#pragma unroll
            for (int t = 0; t < 8; ++t) {
                f32x4 a = S[t] * egl;
                a = mfma16(ldperm(KT + (16 * t + fr) * 72 + 4 * fq), bE0, a);
                a = mfma16(ldperm(KT + (16 * t + fr) * 72 + 32 + 4 * fq), bE1, a);
                S[t] = a;
            }
#pragma unroll
            for (int kb = 0; kb < 4; ++kb) exS[(slice * 4 + kb) * 64 + lane] = pk8(S[2 * kb], S[2 * kb + 1]);
        } else if (wid < 4) {
            const bf16x8 bD0 = exD[(slice * 2 + 0) * 64 + lane], bD1 = exD[(slice * 2 + 1) * 64 + lane];
#pragma unroll
            for (int rt = 0; rt < 4; ++rt) {
                f32x4 a = (f32x4){0.f, 0.f, 0.f, 0.f};
                a = mfma16(ldperm(QK + (16 * rt + fr) * 72 + 4 * fq), bD0, a);
                a = mfma16(ldperm(QK + (16 * rt + fr) * 72 + 32 + 4 * fq), bD1, a);
#pragma unroll
                for (int jj = 0; jj < 4; ++jj) {
                    const int i = 16 * rt + 4 * fq + jj;
                    const float o = egS[i] * QS[rt][jj] + a[jj];
                    mo[(tok0 + n * 64 + i) * DM + h * 128 + dv] = f2bf(o);
                }
            }
        }
        __syncthreads();
        if (n + 1 < 128) GDN_STORE();
        __syncthreads();
    }
#undef GDN_LOAD
#undef GDN_STORE
}

DEV void swa_item(const Params& p, int item) {
    bf16_t* P = (bf16_t*)(p.ws + OFF_P); float* lseG = (float*)(p.ws + OFF_LSE); const float* blut = (const float*)(p.ws + OFF_BLUT);
    bf16_t* Qs = (bf16_t*)g_shm; bf16_t* Ks = Qs + 128 * 72; bf16_t* Vt = Ks + 256 * 72;
    const int tid = opq_tid(), wid = tid >> 6, lane = tid & 63, fr = lane & 15, fq = lane >> 4;
    const int blk64 = item & 63, h = (item >> 6) & 3, g = (item >> 8) % 3, b = item / 768;
    const int d = (g == 0) ? 1 : (g == 1 ? 4 : 16), nb = 64 / d;
    const int res = blk64 / nb, ib = blk64 % nb;
    const size_t tok0 = (size_t)b * SEQ;
    const int qcol = 3072 + g * 256 + h * 64, kcol = 3840 + g * 256 + h * 64, vcol = 4608 + g * 256 + h * 64;
    __syncthreads();
#pragma unroll
    for (int i = 0; i < 2; ++i) { const int idx = tid + 512 * i, a = idx >> 3, c8 = (idx & 7) * 8;
        *(u32x4*)(Qs + a * 72 + c8) = *(const u32x4*)(P + (tok0 + (size_t)(128 * ib + a) * d + res) * LDE + qcol + c8); }
#pragma unroll
    for (int i = 0; i < 4; ++i) { const int idx = tid + 512 * i, kj = idx & 255, c8 = (idx >> 8) * 8; const int sk = 128 * (ib - 1) + kj;
        u32x4 kv = (u32x4){0u, 0u, 0u, 0u}, vv = (u32x4){0u, 0u, 0u, 0u};
        if (sk >= 0) { const size_t tok = tok0 + (size_t)sk * d + res; kv = *(const u32x4*)(P + tok * LDE + kcol + c8); vv = *(const u32x4*)(P + tok * LDE + vcol + c8); }
        *(u32x4*)(Ks + kj * 72 + c8) = kv;
#pragma unroll
        for (int e = 0; e < 4; ++e) { Vt[(c8 + 2 * e) * 264 + kj] = (bf16_t)(vv[e] & 0xffffu); Vt[(c8 + 2 * e + 1) * 264 + kj] = (bf16_t)(vv[e] >> 16); } }
    __syncthreads();
    {
        const int a0 = 16 * wid;
        const bf16x8 bq0 = ld8(Qs + (a0 + fr) * 72 + fq * 8), bq1 = ld8(Qs + (a0 + fr) * 72 + 32 + fq * 8);
        f32x4 s[10];
        float mx = -INFINITY;
        const float* bl = blut + h * NLUT;
#pragma unroll
        for (int kt = 0; kt < 9; ++kt) {
            f32x4 acc = (f32x4){0.f, 0.f, 0.f, 0.f};
            acc = mfma16(ld8(Ks + (a0 + 16 * kt + fr) * 72 + fq * 8), bq0, acc);
            acc = mfma16(ld8(Ks + (a0 + 16 * kt + fr) * 72 + 32 + fq * 8), bq1, acc);
#pragma unroll
            for (int jj = 0; jj < 4; ++jj) {
                const int rel = fr + 128 - 16 * kt - 4 * fq - jj; const int kj = a0 + 16 * kt + 4 * fq + jj;
                const bool ok = (rel >= 0) && (rel <= 128) && (ib > 0 || kj >= 128);
                const int di = min(max(rel, 0) * d, NLUT - 1);
                const float sc = ok ? (acc[jj] * 0.125f + bl[di]) : -INFINITY;
                s[kt][jj] = sc; mx = fmaxf(mx, sc);
            }
        }
        s[9] = (f32x4){-INFINITY, -INFINITY, -INFINITY, -INFINITY};
        mx = fmaxf(mx, __shfl_xor(mx, 16)); mx = fmaxf(mx, __shfl_xor(mx, 32));
        float l = 0.f;
#pragma unroll
        for (int kt = 0; kt < 10; ++kt)
#pragma unroll
            for (int jj = 0; jj < 4; ++jj) { const float pe = __expf(s[kt][jj] - mx); s[kt][jj] = pe; l += pe; }
        l += __shfl_xor(l, 16); l += __shfl_xor(l, 32);
        f32x4 O[4];
#pragma unroll
        for (int dt = 0; dt < 4; ++dt) O[dt] = (f32x4){0.f, 0.f, 0.f, 0.f};
#pragma unroll
        for (int ks = 0; ks < 5; ++ks) {
            const bf16x8 bp = pk8(s[2 * ks], s[2 * ks + 1]);
#pragma unroll
            for (int dt = 0; dt < 4; ++dt) {
                const bf16_t* vp = Vt + (16 * dt + fr) * 264 + a0 + 32 * ks + 4 * fq;
                const u32x2 lo = *(const u32x2*)vp; u32x2 hi = (u32x2){0u, 0u};
                if (ks < 4) hi = *(const u32x2*)(vp + 16);
                O[dt] = mfma16(mk8(lo.x, lo.y, hi.x, hi.y), bp, O[dt]);
            }
        }
        const float inv = 1.0f / l;
        const size_t tok = tok0 + (size_t)(128 * ib + a0 + fr) * d + res;
#pragma unroll
        for (int dt = 0; dt < 4; ++dt) { u32x2 w; w.x = pk2(O[dt][0] * inv, O[dt][1] * inv); w.y = pk2(O[dt][2] * inv, O[dt][3] * inv);
            *(u32x2*)(P + tok * LDE + qcol + 16 * dt + 4 * fq) = w; }
        if (fq == 0) lseG[tok * 12 + g * 4 + h] = mx + __logf(l);
    }
}

DEV void even_post(const Params& p) {
    const bf16_t* P = (const bf16_t*)(p.ws + OFF_P); const float* lseG = (const float*)(p.ws + OFF_LSE); bf16_t* mo = (bf16_t*)(p.ws + OFF_HB);
    const int tid = opq_tid(), wid = tid >> 6, lane = tid & 63;
    const float nw0 = p.gdn_norm_w[2 * lane], nw1 = p.gdn_norm_w[2 * lane + 1];
    const int hh = lane >> 4, d4 = (lane & 15) * 4;
    const int stride = (int)gridDim.x * 8;
#pragma unroll 1
    for (int tok0 = blockIdx.x * 8 + wid; tok0 < MTOK; tok0 += 2 * stride) {
        unsigned raw[2][6], z[2][6]; float ls[2][3]; u32x2 og[2][3];
#pragma unroll
        for (int u = 0; u < 2; ++u) {
            const int tok = min(tok0 + u * stride, MTOK - 1);
#pragma unroll
            for (int h = 0; h < 6; ++h) { raw[u][h] = *(const unsigned*)(mo + (size_t)tok * DM + h * 128 + 2 * lane); z[u][h] = *(const unsigned*)(P + (size_t)tok * LDE + 2304 + h * 128 + 2 * lane); }
#pragma unroll
            for (int g = 0; g < 3; ++g) { ls[u][g] = lseG[(size_t)tok * 12 + g * 4 + hh]; og[u][g] = *(const u32x2*)(P + (size_t)tok * LDE + 3072 + g * 256 + hh * 64 + d4); }
        }
#pragma unroll
        for (int u = 0; u < 2; ++u) {
            const int tok = tok0 + u * stride;
            if (tok < MTOK) {
#pragma unroll
                for (int h = 0; h < 6; ++h) {
                    const float a = lo2f(raw[u][h]), c = hi2f(raw[u][h]);
                    const float rstd = rsqrtf(wsum(a * a + c * c) * (1.0f / 128.0f) + 1e-6f);
                    *(unsigned*)(mo + (size_t)tok * DM + h * 128 + 2 * lane) = pk2(a * rstd * nw0 * silu(lo2f(z[u][h])), c * rstd * nw1 * silu(hi2f(z[u][h])));
                }
                const float l0 = ls[u][0], l1 = ls[u][1], l2 = ls[u][2];
                const float m = fmaxf(l0, fmaxf(l1, l2)); float w0 = __expf(l0 - m), w1 = __expf(l1 - m), w2 = __expf(l2 - m); const float iv = 1.0f / (w0 + w1 + w2); w0 *= iv; w1 *= iv; w2 *= iv;
                const u32x2 o0 = og[u][0], o1 = og[u][1], o2 = og[u][2];
                u32x2 w;
                w.x = pk2(w0 * lo2f(o0.x) + w1 * lo2f(o1.x) + w2 * lo2f(o2.x), w0 * hi2f(o0.x) + w1 * hi2f(o1.x) + w2 * hi2f(o2.x));
                w.y = pk2(w0 * lo2f(o0.y) + w1 * lo2f(o1.y) + w2 * lo2f(o2.y), w0 * hi2f(o0.y) + w1 * hi2f(o1.y) + w2 * hi2f(o2.y));
                *(u32x2*)(mo + (size_t)tok * DM + 768 + hh * 64 + d4) = w;
            }
        }
    }
}

template <int MODE> DEV void diff_scores(const bf16_t* K_, const float* bl, const bf16_t* Qw, int qrow, int k0, int fr, int fq, float SC,
                                         float (&m)[2], float (&l)[2], f32x4 (&O)[2][8], bf16x8 (&bp)[2][2]) {
    const float bfar = bl[NLUT - 1];
#pragma unroll
    for (int c = 0; c < 2; ++c) {
        f32x4 s[4];
        const bf16x8 bq0 = ld8(Qw + fr * 136 + c * 64 + fq * 8), bq1 = ld8(Qw + fr * 136 + c * 64 + 32 + fq * 8);
#pragma unroll
        for (int k4 = 0; k4 < 4; ++k4) {
            f32x4 acc = (f32x4){0.f, 0.f, 0.f, 0.f};
            acc = mfma16(ld8(K_ + (16 * k4 + fr) * 136 + c * 64 + fq * 8), bq0, acc);
            acc = mfma16(ld8(K_ + (16 * k4 + fr) * 136 + c * 64 + 32 + fq * 8), bq1, acc);
            s[k4] = acc;
            asm volatile("" ::: "memory");
        }
        float mt = -INFINITY;
#pragma unroll
        for (int k4 = 0; k4 < 4; ++k4)
#pragma unroll
            for (int jj = 0; jj < 4; ++jj) {
                const int dist = qrow - (k0 + 16 * k4 + 4 * fq + jj);
                float sc;
                if (MODE == 0) sc = s[k4][jj] * SC + bfar;
                else if (MODE == 1) sc = s[k4][jj] * SC + bl[min(dist, NLUT - 1)];
                else { sc = s[k4][jj] * SC + bl[min(max(dist, 0), NLUT - 1)]; if (dist < 0) sc = -INFINITY; }
                s[k4][jj] = sc; mt = fmaxf(mt, sc);
                if (MODE != 0 && jj == 3) asm volatile("" ::: "memory");
            }
        mt = fmaxf(mt, __shfl_xor(mt, 16)); mt = fmaxf(mt, __shfl_xor(mt, 32));
        const float mn = fmaxf(m[c], mt); const float al = ex2(m[c] - mn); m[c] = mn;
        float ls = 0.f;
#pragma unroll
        for (int k4 = 0; k4 < 4; ++k4)
#pragma unroll
            for (int jj = 0; jj < 4; ++jj) { const float pe = ex2(s[k4][jj] - mn); s[k4][jj] = pe; ls += pe; }
        l[c] = l[c] * al + ls;
        bp[c][0] = pk8(s[0], s[1]); bp[c][1] = pk8(s[2], s[3]);
        if (__ballot(al < 1.0f) != 0ull) {
#pragma unroll
            for (int dt = 0; dt < 8; ++dt) O[c][dt] *= al;
        }
        asm volatile("" ::: "memory");
    }
}

DEV void diff_item(const Params& p, int item) {
    const bf16_t* P = (const bf16_t*)(p.ws + OFF_P); bf16_t* mo = (bf16_t*)(p.ws + OFF_HB);
    bf16_t* Ks = (bf16_t*)g_shm;
    bf16_t* Vt = Ks + 2 * 64 * 136;
    float* bl = (float*)(Vt + 2 * 128 * 72);
    bf16_t* Qs = (bf16_t*)(bl + NLUT);
    const int tid = opq_tid(), wid = __builtin_amdgcn_readfirstlane(tid >> 6), lane = tid & 63, fr = lane & 15, fq = lane >> 4;
    const int qb = 63 - (item >> 4), bh = item & 15, b = bh >> 2, h = bh & 3;
    const size_t tok0 = (size_t)b * SEQ;
    const int q0 = qb * 128, qw0 = q0 + 16 * wid, qrow = qw0 + fr;
    const int nkt = 2 * (qb + 1);
    __syncthreads();
    { const float* blg = (const float*)(p.ws + OFF_BLUT) + h * NLUT; for (int i = tid; i < NLUT; i += 512) bl[i] = blg[i] * LOG2E; }
    bf16_t* Qw = Qs + wid * 16 * 136;
#pragma unroll
    for (int c = 0; c < 2; ++c)
#pragma unroll
        for (int kb = 0; kb < 2; ++kb) *(bf16x8*)(Qw + fr * 136 + c * 64 + kb * 32 + fq * 8) = *(const bf16x8*)(P + (tok0 + qrow) * LDO + h * 128 + c * 64 + kb * 32 + fq * 8);
    u32x4 rk[2], rv[2];
#define DF_LOADK(kt_) do { _Pragma("unroll") for (int i = 0; i < 2; ++i) { const int idx = tid + 512 * i, r = idx >> 4, c8 = (idx & 15) * 8; \
        rk[i] = *(const u32x4*)(P + (tok0 + (size_t)(kt_) * 64 + r) * LDO + 512 + h * 128 + c8); } } while (0)
#define DF_LOADV(kt_) do { _Pragma("unroll") for (int i = 0; i < 2; ++i) { const int idx = tid + 512 * i; \
        rv[i] = *(const u32x4*)(P + (tok0 + (size_t)(kt_) * 64 + (idx >> 4)) * LDO + 1024 + h * 128 + (idx & 15) * 8); } } while (0)
#define DF_LOAD(kt_) do { DF_LOADK(kt_); DF_LOADV(kt_); } while (0)
#define DF_STORE(buf_) do { bf16_t* K_ = Ks + (buf_) * 64 * 136; bf16_t* V_ = Vt + (buf_) * 128 * 72; \
        _Pragma("unroll") for (int i = 0; i < 2; ++i) { const int idx = tid + 512 * i, r = idx >> 4, c8 = (idx & 15) * 8; *(u32x4*)(K_ + r * 136 + c8) = rk[i]; \
            { const int vr_ = (idx >> 4) ^ ((idx & 15) * 4), vc_ = (idx & 15) * 8; _Pragma("unroll") for (int e = 0; e < 4; ++e) { V_[(vc_ + 2 * e) * 72 + vr_] = (bf16_t)(rv[i][e] & 0xffffu); V_[(vc_ + 2 * e + 1) * 72 + vr_] = (bf16_t)(rv[i][e] >> 16); } } } } while (0)
    DF_LOAD(0); DF_STORE(0);
    __syncthreads();
    f32x4 O[2][8]; float m[2] = {-INFINITY, -INFINITY}, l[2] = {0.f, 0.f};
#pragma unroll
    for (int c = 0; c < 2; ++c)
#pragma unroll
        for (int dt = 0; dt < 8; ++dt) O[c][dt] = (f32x4){0.f, 0.f, 0.f, 0.f};
    const float SC = 0.125f * LOG2E;
#pragma unroll 1
    for (int kt = 0; kt < nkt; ++kt) {
        const int buf = kt & 1, k0 = kt * 64;
        if (kt + 1 < nkt) DF_LOAD(kt + 1);
        if (k0 <= qw0 + 15) {
            const bf16_t* K_ = Ks + buf * 64 * 136; const bf16_t* V_ = Vt + buf * 128 * 72;
            const bool need_mask = (k0 + 63 > qw0);
            const bool far = (qw0 - (k0 + 63) >= NLUT - 1);
            bf16x8 bp[2][2];
            if (far) diff_scores<0>(K_, bl, Qw, qrow, k0, fr, fq, SC, m, l, O, bp);
            else if (!need_mask) diff_scores<1>(K_, bl, Qw, qrow, k0, fr, fq, SC, m, l, O, bp);
            else diff_scores<2>(K_, bl, Qw, qrow, k0, fr, fq, SC, m, l, O, bp);
            int frv = fr; asm volatile("" : "+v"(frv));
            const int fr8x4 = 4 * (frv >> 3), fq4 = 4 * (frv == fr ? fq : 0);
#pragma unroll
            for (int ks = 0; ks < 2; ++ks)
#pragma unroll
                for (int dt = 0; dt < 8; ++dt) {
                    const int vsw = 8 * dt + fr8x4;
                    const u32x2 alo = *(const u32x2*)(V_ + (16 * dt + frv) * 72 + ((32 * ks + fq4) ^ vsw)), ahi = *(const u32x2*)(V_ + (16 * dt + frv) * 72 + ((32 * ks + 16 + fq4) ^ vsw));
                    const bf16x8 a = mk8(alo.x, alo.y, ahi.x, ahi.y);
                    O[0][dt] = mfma16(a, bp[0][ks], O[0][dt]); O[1][dt] = mfma16(a, bp[1][ks], O[1][dt]);

                }
        }
        if (kt + 1 < nkt) DF_STORE(buf ^ 1);
        __syncthreads();
    }
#undef DF_LOAD
#undef DF_LOADK
#undef DF_LOADV
#undef DF_STORE
    {
        float l0 = l[0], l1 = l[1];
        l0 += __shfl_xor(l0, 16); l0 += __shfl_xor(l0, 32); l1 += __shfl_xor(l1, 16); l1 += __shfl_xor(l1, 32);
        const float lam = *(const float*)(p.ws + OFF_LAM);
        const float i0 = 1.0f / l0, i1 = lam / l1;
        float ss = 0.f;
#pragma unroll
        for (int dt = 0; dt < 8; ++dt) { O[0][dt] = O[0][dt] * i0 - O[1][dt] * i1; ss += (O[0][dt][0] * O[0][dt][0] + O[0][dt][1] * O[0][dt][1]) + (O[0][dt][2] * O[0][dt][2] + O[0][dt][3] * O[0][dt][3]); }
        ss += __shfl_xor(ss, 16); ss += __shfl_xor(ss, 32);
        const float rs = rsqrtf(ss * (1.0f / 128.0f) + 1e-6f) * (1.0f - LAM_INIT);
#pragma unroll
        for (int dt = 0; dt < 8; ++dt) {
            const f32x4 nw = *(const f32x4*)(p.diff_norm_w + 16 * dt + 4 * fq);
            u32x2 w; w.x = pk2(O[0][dt][0] * rs * nw[0], O[0][dt][1] * rs * nw[1]); w.y = pk2(O[0][dt][2] * rs * nw[2], O[0][dt][3] * rs * nw[3]);
            *(u32x2*)(mo + (tok0 + qrow) * DM + h * 128 + 16 * dt + 4 * fq) = w;
        }
    }
}

DEV void gla_task(const Params& p, int task) {
    const bf16_t* P = (const bf16_t*)(p.ws + OFF_P); bf16_t* mo = (bf16_t*)(p.ws + OFF_HB); const float* thin = (const float*)(p.ws + OFF_THIN);
    bf16_t* qt = (bf16_t*)g_shm; bf16_t* kt = qt + 64 * 72; bf16_t* khT = kt + 64 * 72; bf16_t* vT = khT + 64 * 72; bf16_t* at = vT + 128 * 72;
    float* bL = (float*)(at + 64 * 72); float* el = bL + 64 * 65; float* ssq = el + 64;
    float* thL = ssq + 512; bf16_t* rL = (bf16_t*)(thL + 1024);
    const int tid = opq_tid(), wid = tid >> 6, lane = tid & 63, fr = lane & 15, fq = lane >> 4;
    const int b = task >> 2, h = task & 3; const size_t tok0 = (size_t)b * SEQ;
    const int kch = tid & 63;
    float wg[16];
#pragma unroll
    for (int j = 0; j < 16; ++j) wg[j] = p.gla_w_gate[j * 256 + h * 64 + kch];
    const float bgate = p.gla_b_gate[h * 64 + kch];
    const int dv = 16 * wid + fr;
    f32x4 S[4];
#pragma unroll
    for (int t = 0; t < 4; ++t) S[t] = (f32x4){0.f, 0.f, 0.f, 0.f};
    u32x4 pq, pk_, pv[2]; f32x4 pth = (f32x4){0.f, 0.f, 0.f, 0.f};
#define GLA_LOAD(n_) do { const size_t tn_ = tok0 + (size_t)(n_) * 64; \
        pq = *(const u32x4*)(P + (tn_ + (tid & 63)) * LDO + 1536 + h * 64 + (tid >> 6) * 8); pk_ = *(const u32x4*)(P + (tn_ + (tid & 63)) * LDO + 1792 + h * 64 + (tid >> 6) * 8); \
        _Pragma("unroll") for (int i = 0; i < 2; ++i) { const int idx = tid + 512 * i; pv[i] = *(const u32x4*)(P + (tn_ + (idx & 63)) * LDO + 2048 + h * 128 + (idx >> 6) * 8); \
            } \
        if (tid < 256) pth = *(const f32x4*)(thin + (tn_ + (tid >> 2)) * 16 + (tid & 3) * 4); } while (0)
#define GLA_STORE_TR() do { if (tid < 256) *(f32x4*)(thL + (tid >> 2) * 16 + (tid & 3) * 4) = pth; } while (0)
    __syncthreads();
    GLA_LOAD(0); GLA_STORE_TR();
    __syncthreads();
#pragma unroll 1
    for (int n = 0; n < 128; ++n) {
        const size_t t0 = tok0 + (size_t)n * 64;
#pragma unroll
        for (int it = 0; it < 8; ++it) {
            const int r = (tid >> 6) + 8 * it; const float* gd = thL + r * 16;
            float x = bgate;
#pragma unroll
            for (int j = 0; j < 16; ++j) x += gd[j] * wg[j];
            const float ls = (x < -15.f) ? x : -__logf(1.0f + __expf(-x));
            bL[r * 65 + kch] = ls * (1.0f / 16.0f);
        }
        __syncthreads();
        {
            const int part = tid >> 6; float loc[8]; float run = 0.f;
#pragma unroll
            for (int q = 0; q < 8; ++q) { run += bL[(part * 8 + q) * 65 + kch]; loc[q] = run; }
            ssq[part * 64 + kch] = run;
            __syncthreads();
            float off = 0.f;
#pragma unroll
            for (int q = 0; q < 7; ++q) off += (q < part) ? ssq[q * 64 + kch] : 0.f;
#pragma unroll
            for (int q = 0; q < 8; ++q) bL[(part * 8 + q) * 65 + kch] = loc[q] + off;
            if (part == 7) el[kch] = __expf(loc[7] + off);
        }
        __syncthreads();
        {
            const int r = tid & 63, c8 = (tid >> 6) * 8;
            const u32x4 qr = pq, kr = pk_;
            float qf[8], kf[8], kh[8];
#pragma unroll
            for (int e = 0; e < 4; ++e) { qf[2 * e] = lo2f(qr[e]); qf[2 * e + 1] = hi2f(qr[e]); kf[2 * e] = lo2f(kr[e]); kf[2 * e + 1] = hi2f(kr[e]); }
#pragma unroll
            for (int e = 0; e < 8; ++e) { const float bb = bL[r * 65 + c8 + e], blast = bL[63 * 65 + c8 + e];
                qf[e] *= 0.125f * __expf(bb); kh[e] = kf[e] * __expf(blast - bb); kf[e] *= __expf(fminf(-bb, 80.f)); }
            u32x4 w; w.x = pk2(qf[0], qf[1]); w.y = pk2(qf[2], qf[3]); w.z = pk2(qf[4], qf[5]); w.w = pk2(qf[6], qf[7]); *(u32x4*)(qt + r * 72 + c8) = w;
            w.x = pk2(kf[0], kf[1]); w.y = pk2(kf[2], kf[3]); w.z = pk2(kf[4], kf[5]); w.w = pk2(kf[6], kf[7]); *(u32x4*)(kt + r * 72 + c8) = w;
#pragma unroll
            for (int e = 0; e < 8; ++e) khT[(c8 + e) * 72 + r] = f2bf(kh[e]);
#pragma unroll
            for (int i = 0; i < 2; ++i) { const int idx = tid + 512 * i, rr = idx & 63, v8 = (idx >> 6) * 8; const u32x4 vr = pv[i];
#pragma unroll
                for (int e = 0; e < 4; ++e) { vT[(v8 + 2 * e) * 72 + rr] = (bf16_t)(vr[e] & 0xffffu); vT[(v8 + 2 * e + 1) * 72 + rr] = (bf16_t)(vr[e] >> 16); } }
        }
        if (n + 1 < 128) GLA_LOAD(n + 1);
        __syncthreads();
#pragma unroll
        for (int tt = 0; tt < 2; ++tt) {
            const int tile = 2 * wid + tt, itile = tile >> 2, jt = tile & 3;
            f32x4 acc = (f32x4){0.f, 0.f, 0.f, 0.f};
            if (jt <= itile) {
#pragma unroll
                for (int kb = 0; kb < 2; ++kb) acc = mfma16(ld8(qt + (16 * itile + fr) * 72 + kb * 32 + fq * 8), ld8(kt + (16 * jt + fr) * 72 + kb * 32 + fq * 8), acc);
            }
#pragma unroll
            for (int jj = 0; jj < 4; ++jj) { const int i = 16 * itile + 4 * fq + jj, j = 16 * jt + fr; at[i * 72 + j] = (i >= j) ? f2bf(acc[jj]) : (bf16_t)0; }
        }
        __syncthreads();
        f32x4 o[4];
        {
            const bf16x8 bS0 = pk8(S[0], S[1]), bS1 = pk8(S[2], S[3]);
            const bf16x8 bv0 = ld8(vT + dv * 72 + fq * 8), bv1 = ld8(vT + dv * 72 + 32 + fq * 8);
#pragma unroll
            for (int rt = 0; rt < 4; ++rt) {
                f32x4 a = (f32x4){0.f, 0.f, 0.f, 0.f};
                a = mfma16(ldperm(qt + (16 * rt + fr) * 72 + 4 * fq), bS0, a);
                a = mfma16(ldperm(qt + (16 * rt + fr) * 72 + 32 + 4 * fq), bS1, a);
                a = mfma16(ld8(at + (16 * rt + fr) * 72 + fq * 8), bv0, a);
                a = mfma16(ld8(at + (16 * rt + fr) * 72 + 32 + fq * 8), bv1, a);
                o[rt] = a;
            }
#pragma unroll
            for (int t = 0; t < 4; ++t) {
                f32x4 a;
#pragma unroll
                for (int jj = 0; jj < 4; ++jj) a[jj] = S[t][jj] * el[16 * t + 4 * fq + jj];
                a = mfma16(ld8(khT + (16 * t + fr) * 72 + fq * 8), bv0, a);
                a = mfma16(ld8(khT + (16 * t + fr) * 72 + 32 + fq * 8), bv1, a);
                S[t] = a;
            }
#pragma unroll
            for (int rt = 0; rt < 4; ++rt)
#pragma unroll
                for (int jj = 0; jj < 4; ++jj) mo[(t0 + 16 * rt + 4 * fq + jj) * DM + 512 + h * 128 + dv] = f2bf(o[rt][jj]);
        }
        if (n + 1 < 128) GLA_STORE_TR();
        __syncthreads();
    }
#undef GLA_LOAD
#undef GLA_STORE_TR
}

DEV void odd_post(const Params& p) {
    const bf16_t* P = (const bf16_t*)(p.ws + OFF_P); bf16_t* mo = (bf16_t*)(p.ws + OFF_HB);
    const int tid = opq_tid(), wid = tid >> 6, lane = tid & 63;
    const float nw0 = p.gla_norm_w[2 * lane], nw1 = p.gla_norm_w[2 * lane + 1];
    const int stride = (int)gridDim.x * 8;
#pragma unroll 1
    for (int tok0 = blockIdx.x * 8 + wid; tok0 < MTOK; tok0 += 2 * stride) {
        unsigned raw[2][4], z[2][4];
#pragma unroll
        for (int u = 0; u < 2; ++u) {
            const int tok = min(tok0 + u * stride, MTOK - 1);
#pragma unroll
            for (int h = 0; h < 4; ++h) { raw[u][h] = *(const unsigned*)(mo + (size_t)tok * DM + 512 + h * 128 + 2 * lane); z[u][h] = *(const unsigned*)(P + (size_t)tok * LDO + 2560 + h * 128 + 2 * lane); }
        }
#pragma unroll
        for (int u = 0; u < 2; ++u) {
            const int tok = tok0 + u * stride;
            if (tok < MTOK) {
#pragma unroll
                for (int h = 0; h < 4; ++h) {
                    const float a = lo2f(raw[u][h]), c = hi2f(raw[u][h]);
                    const float rstd = __builtin_amdgcn_rsqf(wsum(a * a + c * c) * (1.0f / 128.0f) + 1e-6f);
                    *(unsigned*)(mo + (size_t)tok * DM + 512 + h * 128 + 2 * lane) = pk2(a * rstd * nw0 * silu(lo2f(z[u][h])), c * rstd * nw1 * silu(hi2f(z[u][h])));
                }
            }
        }
    }
}

#ifndef PH_LO
#define PH_LO 0
#define PH_HI 99
#endif
#define PHASE(k) if ((k) >= PH_LO && (k) <= PH_HI)
#ifdef MULTI_LAUNCH
#define GSYNC()
#define GSYNC_CG()
#else
#define GSYNC() xcd_barrier(xb)
#define GSYNC_CG() grid.sync()
#endif

template <int LO, int HI> __global__ void __launch_bounds__(512, 2) mega(Params kp) {
#ifndef MULTI_LAUNCH
    cg::grid_group grid = cg::this_grid();
    volatile XB_LAS unsigned* xst = (volatile XB_LAS unsigned*)(g_shm + 131072);
    if (threadIdx.x == 0) { xst[0] = 0u; xst[1] = 0u; }
    __syncthreads();
    const XcdBarrier xb = xcd_barrier_post((unsigned*)(kp.ws + OFF_BAR), xst);
    if (threadIdx.x == 0) xst[2] = xb_add(&((unsigned*)(kp.ws + OFF_BAR))[3456 + 16 * xb.x], 1u);
    __syncthreads();
#endif
    unsigned char* const wsb = (unsigned char*)(((unsigned long long)(unsigned)__builtin_amdgcn_readfirstlane((int)((unsigned long long)kp.ws >> 32)) << 32) | (unsigned)__builtin_amdgcn_readfirstlane((int)(unsigned)(unsigned long long)kp.ws));
#define P ((bf16_t*)(wsb + OFF_P))
#define HB ((bf16_t*)(wsb + OFF_HB))
#define WT ((bf16_t*)(wsb + OFF_WT))
#define thin ((float*)(wsb + OFF_THIN))
#define STEP(k) if ((k) >= LO && (k) <= HI)
#ifndef REPK
#define REPK -1
#endif
#define NREP(k) (((k) == REPK) ? 2 : 1)
    STEP(0) { const Params& p = kp; phase_weights(p); rowpass(p.x, nullptr, nullptr, HB, nullptr, nullptr, p.w_in_even + 3072, 5388, 12, thin); }
    if (0 >= LO && 0 < HI) { if (wsb == nullptr) GSYNC_CG(); GSYNC(); }
#ifndef MULTI_LAUNCH
    {
        unsigned* barw = (unsigned*)(wsb + OFF_BAR); bool ok = (gridDim.x % 8u) == 0u; unsigned npop = 0u;
        for (unsigned j = 0; j < 16; ++j) { const unsigned cj = xb_ld(&barw[XB_XCNT(j)]); if (cj) { ++npop; ok = ok && (j < 8u) && (cj == gridDim.x / 8u); } }
        ok = ok && (npop == 8u);
        if (threadIdx.x == 0) xst[3] = ok ? (xst[2] * 8u + xb.x) : blockIdx.x;
        __syncthreads();
    }
#define gemm_c ((int)__builtin_amdgcn_readfirstlane((int)xst[3]))
#else
#define gemm_c ((int)blockIdx.x)
#endif
    STEP(1) for (int rep = 0; rep < NREP(1); ++rep) { const Params p = load_params(wsb); if (rep) GSYNC(); EpiStoreBf16 E; E.O = P; E.ldc = LDE; E.halo = (bf16_t*)(p.ws + OFF_HALO1); E.seg = 64; E.hrows = 3; E.hcols = 2304; run_gemm(gemm_c, HB, DM, WT + W_INE, MTOK, LDE, DM, E); }
    if (1 >= LO && 1 < HI) GSYNC();
    STEP(2) { const Params p = load_params(wsb); gdn_prep(p); }
    if (2 >= LO && 2 < HI) GSYNC();
    STEP(3) { const Params p = load_params(wsb);
        for (int task = blockIdx.x; task < 96; task += gridDim.x) gdn_scan(p, task);
        const int nsw = (int)gridDim.x > 96 ? (int)gridDim.x - 96 : (int)gridDim.x; const int first = (int)gridDim.x > 96 ? (int)blockIdx.x - 96 : (int)blockIdx.x;
        if (first >= 0) for (int item = first; item < 3072; item += nsw) swa_item(p, item);
        {
            unsigned* cnt2 = (unsigned*)(p.ws + OFF_CNT) + 32; int* s_item_p = (int*)(g_shm + 131056);
            for (;;) {
                __syncthreads();
                if (threadIdx.x == 0) *s_item_p = (int)atomicAdd(cnt2, 1u);
                __syncthreads();
                const int t = *s_item_p + 1600;
                if (t >= 6848) break;
                cvt_weight_tile(p, t);
            }
        }
    }
    if (3 >= LO && 3 < HI) GSYNC();
    STEP(4) { const Params p = load_params(wsb); even_post(p); }
    if (4 >= LO && 4 < HI) GSYNC();
    STEP(5) for (int rep = 0; rep < NREP(5); ++rep) { const Params p = load_params(wsb); if (rep) GSYNC(); EpiStoreBf16 E; E.O = P + 2816; E.ldc = LDF; E.halo = nullptr; E.seg = 64; E.hrows = 0; E.hcols = 0; run_gemm(gemm_c, HB, DM, WT + W_OUTE, MTOK, DM, DM, E); }
    if (5 >= LO && 5 < HI) GSYNC();
    STEP(6) { const Params p = load_params(wsb); rowpass(p.x, P + 2816, p.out, HB, p.ln_g, p.ln_b, nullptr, 0, 0, nullptr); }
    if (6 >= LO && 6 < HI) GSYNC();
    STEP(7) for (int rep = 0; rep < NREP(7); ++rep) { const Params p = load_params(wsb); if (rep) GSYNC(); EpiStoreBf16 E; E.O = P; E.ldc = LDF; E.halo = (bf16_t*)(p.ws + OFF_HALO2); E.seg = 128; E.hrows = 2; E.hcols = 5632; run_gemm(gemm_c, HB, DM, WT + W_UP0, MTOK, LDF, DM, E); }
    if (7 >= LO && 7 < HI) GSYNC();
    STEP(8) { const Params p = load_params(wsb); convgate(p, 0); }
    if (8 >= LO && 8 < HI) GSYNC();
    STEP(9) { const Params p = load_params(wsb); EpiStoreBf16 E; E.O = P + 2816; E.ldc = LDF; E.halo = nullptr; E.seg = 64; E.hrows = 0; E.hcols = 0; run_gemm(gemm_c, P, LDF, WT + W_DN0, MTOK, DM, 2816, E); }
    if (9 >= LO && 9 < HI) GSYNC();
    STEP(10) { const Params p = load_params(wsb); rowpass(p.out, P + 2816, p.out, HB, p.ln_g + 1024, p.ln_b + 1024, p.w_in_odd + 3072, 3088, 16, thin); }
    if (10 >= LO && 10 < HI) GSYNC();
    STEP(11) for (int rep = 0; rep < NREP(11); ++rep) { const Params p = load_params(wsb); if (rep) GSYNC(); EpiStoreBf16 E; E.O = P; E.ldc = LDO; E.halo = nullptr; E.seg = 64; E.hrows = 0; E.hcols = 0; run_gemm(gemm_c, HB, DM, WT + W_INO, MTOK, LDO, DM, E); }
    if (11 >= LO && 11 < HI) GSYNC();
    STEP(12) for (int rep = 0; rep < NREP(12); ++rep) { const Params p = load_params(wsb);
        if (rep) GSYNC();
#ifdef REP_NOGLA
        if (rep == 0)
#endif
        for (int task = blockIdx.x; task < 16; task += gridDim.x) gla_task(p, task);
        unsigned* cnt = (unsigned*)(p.ws + OFF_CNT) + 16 * rep; int* s_item_p = (int*)(g_shm + 131056);
        for (;;) {
            __syncthreads();
            if (threadIdx.x == 0) *s_item_p = (int)atomicAdd(cnt, 1u);
            __syncthreads();
            const int item = *s_item_p;
            if (item >= 1024) break;
            diff_item(p, item);
        }
    }
    if (12 >= LO && 12 <= HI) GSYNC();
    STEP(12) { const Params p = load_params(wsb); odd_post(p); }
    if (12 >= LO && 12 < HI) GSYNC();
    STEP(13) { const Params p = load_params(wsb); EpiStoreBf16 E; E.O = P + 2816; E.ldc = LDF; E.halo = nullptr; E.seg = 64; E.hrows = 0; E.hcols = 0; run_gemm(gemm_c, HB, DM, WT + W_OUTO, MTOK, DM, DM, E); }
    if (13 >= LO && 13 < HI) GSYNC();
    STEP(14) { const Params p = load_params(wsb); rowpass(p.out, P + 2816, p.out, HB, p.ln_g + 2048, p.ln_b + 2048, nullptr, 0, 0, nullptr); }
    if (14 >= LO && 14 < HI) GSYNC();
    STEP(15) for (int rep = 0; rep < NREP(15); ++rep) { const Params p = load_params(wsb); if (rep) GSYNC(); EpiStoreBf16 E; E.O = P; E.ldc = LDF; E.halo = (bf16_t*)(p.ws + OFF_HALO2); E.seg = 128; E.hrows = 2; E.hcols = 5632; run_gemm(gemm_c, HB, DM, WT + W_UP1, MTOK, LDF, DM, E); }
    if (15 >= LO && 15 < HI) GSYNC();
    STEP(16) { const Params p = load_params(wsb); convgate(p, 1); }
    if (16 >= LO && 16 < HI) GSYNC();
    STEP(17) { const Params p = load_params(wsb); EpiStoreBf16 E; E.O = P + 2816; E.ldc = LDF; E.halo = nullptr; E.seg = 64; E.hrows = 0; E.hcols = 0; run_gemm(gemm_c, P, LDF, WT + W_DN1, MTOK, DM, 2816, E); }
    if (17 >= LO && 17 < HI) GSYNC();
    STEP(18) { const Params p = load_params(wsb); rowpass(p.out, P + 2816, p.out, nullptr, p.ln_g + 3072, p.ln_b + 3072, nullptr, 0, 0, nullptr); }
#undef STEP
#undef gemm_c
#undef P
#undef HB
#undef WT
#undef thin
}

#ifdef DUMP_ODD
__global__ void dump_odd(Params p) {
    const bf16_t* P = (const bf16_t*)(p.ws + OFF_P); const float* thin = (const float*)(p.ws + OFF_THIN);
    for (size_t i = (size_t)blockIdx.x * 512 + threadIdx.x; i < (size_t)MTOK * 1024; i += (size_t)gridDim.x * 512) {
        const size_t row = i >> 10; const int c = (int)(i & 1023);
        p.out[i] = c < 16 ? thin[row * 16 + c] : bf2f(P[row * LDO + 1536 + c]);
    }
}
#endif
constexpr size_t kDynLds = 131072 + 64;

extern "C" void kernel_launch(void* const* d_in, const int* in_sizes, int n_in, void* d_out, int out_size, void* d_ws, size_t ws_size, hipStream_t stream) {
    (void)in_sizes; (void)n_in; (void)out_size;
    if (ws_size < WS_NEED) { fprintf(stderr, "workspace too small: %zu < %zu\n", ws_size, (size_t)WS_NEED); return; }
    Params p{};
    const float** f = (const float**)&p;
    for (int i = 0; i < 21; ++i) f[i] = (const float*)d_in[i];
    p.out = (float*)d_out; p.ws = (unsigned char*)d_ws;
#ifdef MULTI_LAUNCH
    static bool attr = false;
#define LAUNCH1(k) do { hipFuncSetAttribute((const void*)mega<k, k>, hipFuncAttributeMaxDynamicSharedMemorySize, (int)kDynLds); \
        hipLaunchKernelGGL((mega<k, k>), dim3(256), dim3(512), kDynLds, stream, p); } while (0)
#ifndef LASTPH
#define LASTPH 18
#endif
#define LAUNCHIF(k) do { if ((k) <= LASTPH) LAUNCH1(k); } while (0)
    LAUNCHIF(0); LAUNCHIF(1); LAUNCHIF(2); LAUNCHIF(3); LAUNCHIF(4); LAUNCHIF(5); LAUNCHIF(6); LAUNCHIF(7); LAUNCHIF(8); LAUNCHIF(9);
    LAUNCHIF(10); LAUNCHIF(11); LAUNCHIF(12); LAUNCHIF(13); LAUNCHIF(14); LAUNCHIF(15); LAUNCHIF(16); LAUNCHIF(17); LAUNCHIF(18);
    (void)attr;
#ifdef DUMP_ODD
    hipLaunchKernelGGL(dump_odd, dim3(1024), dim3(512), 0, stream, p);
#endif
#else
    static int grid_blocks = 0;
    if (!grid_blocks) {
        int dev = 0, cus = 0, per_cu = 0;
        hipGetDevice(&dev);
        hipDeviceGetAttribute(&cus, hipDeviceAttributeMultiprocessorCount, dev);
        hipFuncSetAttribute((const void*)mega<0, 99>, hipFuncAttributeMaxDynamicSharedMemorySize, (int)kDynLds);
        hipOccupancyMaxActiveBlocksPerMultiprocessor(&per_cu, mega<0, 99>, 512, kDynLds);
        if (per_cu < 1) per_cu = 1;
        grid_blocks = cus * per_cu;
        if (grid_blocks > 256) grid_blocks = 256;
    }
    hipMemsetAsync((unsigned char*)d_ws + OFF_BAR, 0, 16384, stream);
    void* args[] = {&p};
    hipError_t e = hipLaunchCooperativeKernel((void*)mega<0, 99>, dim3(grid_blocks), dim3(512), args, kDynLds, stream);
    if (e != hipSuccess) fprintf(stderr, "cooperative launch failed: %s (grid %d)\n", hipGetErrorString(e), grid_blocks);
#endif
}
```
